# Optimizing an MI355X kernel written in HIP

```python
import jax, jax.numpy as jnp
from jax import lax
import numpy as np

D_MODEL = 1024
BATCH = 8
SEQ = 2048
DEPTH = 2
DEC_BATCH = 128
DEC_SEQ = 1
PAST_LEN = 16384
PAGE_SIZE = 128

MIX_WIDTH = D_MODEL
GLA_WIDTH = MIX_WIDTH // 2
RET_WIDTH = MIX_WIDTH - GLA_WIDTH
GLA_HEADS = 4
GLA_DV = GLA_WIDTH // GLA_HEADS
GLA_DK = GLA_DV // 2
GLA_RANK = 16
GLA_GATE_TAU = 16.0
RET_HEADS = 4
RET_DV = RET_WIDTH // RET_HEADS
RET_DK = RET_DV // 2
IN_COLS = (2 * GLA_HEADS * GLA_DK + 2 * GLA_WIDTH + GLA_RANK
           + 2 * RET_HEADS * RET_DK + 2 * RET_WIDTH)
CHUNK = 64
ROPE_BASE = 10000.0
EPS = 1e-6
GN_EPS = 1e-5

kernel_name = 'hymba_gla_retnet_hybrid_step'

F32 = jnp.float32


def _rmsnorm(x, w):
    xf = x.astype(F32)
    y = xf * lax.rsqrt(jnp.mean(xf * xf, axis=-1, keepdims=True) + EPS) * w.astype(F32)
    return y.astype(x.dtype)


def _split_cols(z):
    sizes = (GLA_HEADS * GLA_DK, GLA_HEADS * GLA_DK, GLA_WIDTH, GLA_WIDTH, GLA_RANK,
             RET_HEADS * RET_DK, RET_HEADS * RET_DK, RET_WIDTH, RET_WIDTH)
    offs = np.cumsum(sizes)[:-1].tolist()
    return jnp.split(z, offs, axis=-1)


def _rope(x, pos):
    half = x.shape[-1] // 2
    inv = ROPE_BASE ** (-jnp.arange(half, dtype=F32) / half)
    ang = pos.astype(F32)[:, None] * inv[None, :]
    cos = jnp.cos(ang)[:, None, :]
    sin = jnp.sin(ang)[:, None, :]
    x1, x2 = x[..., :half], x[..., half:]
    return jnp.concatenate([x1 * cos - x2 * sin, x1 * sin + x2 * cos], axis=-1)


def _ret_log_gamma():
    return jnp.log(1.0 - jnp.power(2.0, -5.0 - jnp.arange(RET_HEADS, dtype=F32)))


def _to_chunks(a):
    b, t, h, d = a.shape
    return a.reshape(b, t // CHUNK, CHUNK, h, d).transpose(1, 0, 3, 2, 4)


def _from_chunks(o):
    n, b, h, c, d = o.shape
    return o.transpose(1, 0, 3, 2, 4).reshape(b, n * c, h, d)


def _gla_chunked(q, k, v, la, s0):
    mask = jnp.tril(jnp.ones((CHUNK, CHUNK), dtype=bool))

    def step(s, xs):
        qc, kc, vc, lc = xs
        b = jnp.cumsum(lc, axis=2)
        qd = qc * jnp.exp(b)
        kd = kc * jnp.exp(-b)
        att = jnp.where(mask, jnp.einsum('bhtk,bhsk->bhts', qd, kd), 0.0)
        o = jnp.einsum('bhts,bhsv->bhtv', att, vc) + jnp.einsum('bhtk,bhkv->bhtv', qd, s)
        b_last = b[:, :, -1:, :]
        s_new = (jnp.exp(b_last[:, :, 0, :])[..., None] * s
                 + jnp.einsum('bhsk,bhsv->bhkv', kc * jnp.exp(b_last - b), vc))
        return s_new, o

    s, o = lax.scan(step, s0, (_to_chunks(q), _to_chunks(k), _to_chunks(v), _to_chunks(la)))
    return _from_chunks(o), s


def _gla_recurrent(q, k, v, la, s0):
    def step(s, xs):
        qt, kt, vt, lt = xs
        s = jnp.exp(lt)[..., None] * s + kt[..., None] * vt[..., None, :]
        return s, jnp.einsum('bhk,bhkv->bhv', qt, s)

    s, o = lax.scan(step, s0, (q.swapaxes(0, 1), k.swapaxes(0, 1), v.swapaxes(0, 1), la.swapaxes(0, 1)))
    return o.swapaxes(0, 1), s


def _ret_chunked(q, k, v, s0):
    lg = _ret_log_gamma()
    idx = jnp.arange(CHUNK, dtype=F32)
    rel = idx[:, None] - idx[None, :]
    dmat = jnp.where(rel >= 0, jnp.exp(lg[:, None, None] * jnp.maximum(rel, 0.0)), 0.0)
    q_dec = jnp.exp(lg[:, None] * (idx + 1.0)[None, :])[None, :, :, None]
    k_dec = jnp.exp(lg[:, None] * (CHUNK - 1.0 - idx)[None, :])[None, :, :, None]
    chunk_dec = jnp.exp(lg * CHUNK)[None, :, None, None]

    def step(s, xs):
        qc, kc, vc = xs
        att = jnp.einsum('bhtk,bhsk->bhts', qc, kc) * dmat[None]
        o = jnp.einsum('bhts,bhsv->bhtv', att, vc) + jnp.einsum('bhtk,bhkv->bhtv', qc * q_dec, s)
        s_new = chunk_dec * s + jnp.einsum('bhsk,bhsv->bhkv', kc * k_dec, vc)
        return s_new, o

    s, o = lax.scan(step, s0, (_to_chunks(q), _to_chunks(k), _to_chunks(v)))
    return _from_chunks(o), s


def _ret_recurrent(q, k, v, s0):
    gamma = jnp.exp(_ret_log_gamma())[None, :, None, None]

    def step(s, xs):
        qt, kt, vt = xs
        s = gamma * s + kt[..., None] * vt[..., None, :]
        return s, jnp.einsum('bhk,bhkv->bhv', qt, s)

    s, o = lax.scan(step, s0, (q.swapaxes(0, 1), k.swapaxes(0, 1), v.swapaxes(0, 1)))
    return o.swapaxes(0, 1), s


def _layer(x, pos, s_gla, s_ret, norm_w, w_in, gla_w2, gla_b, gla_norm_w,
           ret_norm_w, ret_norm_b, w_out, chunked):
    B, T, _ = x.shape
    h = _rmsnorm(x, norm_w)
    z = jnp.einsum('btd,dc->btc', h, w_in).astype(F32)
    gq, gk, gv, gg, glr, rq, rk, rv, rg = _split_cols(z)
    q_a = gq.reshape(B, T, GLA_HEADS, GLA_DK) * (GLA_DK ** -0.5)
    k_a = gk.reshape(B, T, GLA_HEADS, GLA_DK)
    v_a = gv.reshape(B, T, GLA_HEADS, GLA_DV)
    la = (jax.nn.log_sigmoid(glr @ gla_w2.astype(F32) + gla_b.astype(F32)) / GLA_GATE_TAU
          ).reshape(B, T, GLA_HEADS, GLA_DK)
    q_b = _rope(rq.reshape(B, T, RET_HEADS, RET_DK), pos)
    k_b = _rope(rk.reshape(B, T, RET_HEADS, RET_DK), pos) * (RET_DK ** -0.5)
    v_b = rv.reshape(B, T, RET_HEADS, RET_DV)
    if chunked:
        o_a, s_gla_new = _gla_chunked(q_a, k_a, v_a, la, s_gla)
        o_b, s_ret_new = _ret_chunked(q_b, k_b, v_b, s_ret)
    else:
        o_a, s_gla_new = _gla_recurrent(q_a, k_a, v_a, la, s_gla)
        o_b, s_ret_new = _ret_recurrent(q_b, k_b, v_b, s_ret)
    o_a = o_a * lax.rsqrt(jnp.mean(o_a * o_a, axis=-1, keepdims=True) + EPS) * gla_norm_w.astype(F32)
    o_a = o_a.reshape(B, T, GLA_WIDTH) * jax.nn.silu(gg)
    mu = jnp.mean(o_b, axis=-1, keepdims=True)
    var = jnp.mean(jnp.square(o_b - mu), axis=-1, keepdims=True)
    o_b = ((o_b - mu) * lax.rsqrt(var + GN_EPS)).reshape(B, T, RET_WIDTH)
    o_b = (o_b * ret_norm_w.astype(F32) + ret_norm_b.astype(F32)) * jax.nn.silu(rg)
    mixed = jnp.concatenate([o_a, o_b], axis=-1).astype(x.dtype)
    y = x + jnp.einsum('btc,cd->btd', mixed, w_out)
    return y, s_gla_new, s_ret_new


def setup_inputs(seed: int = 0) -> dict:
    key = jax.random.key(seed)
    ks = jax.random.split(key, 14)
    nrm = jax.random.normal
    return {
        'x_prompt': nrm(ks[0], (BATCH, SEQ, D_MODEL), F32),
        'x_sample': nrm(ks[1], (DEC_BATCH, DEC_SEQ, D_MODEL), F32),
        'state_gla': nrm(ks[2], (DEPTH, DEC_BATCH, GLA_HEADS, GLA_DK, GLA_DV), F32),
        'state_ret': nrm(ks[3], (DEPTH, DEC_BATCH, RET_HEADS, RET_DK, RET_DV), F32),
        'norm_w': 1.0 + 0.05 * nrm(ks[4], (DEPTH, D_MODEL), F32),
        'w_in': nrm(ks[5], (DEPTH, D_MODEL, IN_COLS), F32) * D_MODEL ** -0.5,
        'gla_w2': nrm(ks[6], (DEPTH, GLA_RANK, GLA_HEADS * GLA_DK), F32) * GLA_RANK ** -0.5,
        'gla_b': 0.1 * nrm(ks[7], (DEPTH, GLA_HEADS * GLA_DK), F32),
        'gla_norm_w': 1.0 + 0.05 * nrm(ks[8], (DEPTH, GLA_DV), F32),
        'ret_norm_w': 1.0 + 0.05 * nrm(ks[9], (DEPTH, RET_WIDTH), F32),
        'ret_norm_b': 0.02 * nrm(ks[10], (DEPTH, RET_WIDTH), F32),
        'w_out': nrm(ks[11], (DEPTH, MIX_WIDTH, D_MODEL), F32) * MIX_WIDTH ** -0.5,
        'final_norm_w': 1.0 + 0.05 * nrm(ks[12], (D_MODEL,), F32),
    }


def reference(x_prompt, x_sample, state_gla, state_ret, norm_w, w_in, gla_w2, gla_b,
              gla_norm_w, ret_norm_w, ret_norm_b, w_out, final_norm_w):
    bp, tp, _ = x_prompt.shape
    bs, ts, _ = x_sample.shape
    pos_p = jnp.arange(tp, dtype=jnp.int32)
    pos_s = PAST_LEN + jnp.arange(ts, dtype=jnp.int32)
    hp, hs = x_prompt, x_sample
    gla_p, ret_p, gla_s, ret_s = [], [], [], []
    for l in range(DEPTH):
        w = (norm_w[l], w_in[l], gla_w2[l], gla_b[l], gla_norm_w[l], ret_norm_w[l], ret_norm_b[l], w_out[l])
        z_gla = jnp.zeros((bp, GLA_HEADS, GLA_DK, GLA_DV), F32)
        z_ret = jnp.zeros((bp, RET_HEADS, RET_DK, RET_DV), F32)
        hp, sg, sr = _layer(hp, pos_p, z_gla, z_ret, *w, chunked=True)
        gla_p.append(sg)
        ret_p.append(sr)
        hs, sg, sr = _layer(hs, pos_s, state_gla[l].astype(F32), state_ret[l].astype(F32), *w, chunked=False)
        gla_s.append(sg)
        ret_s.append(sr)
    y_prompt = _rmsnorm(hp, final_norm_w)
    y_sample = _rmsnorm(hs, final_norm_w)
    gla_state_prompt = jnp.stack(gla_p).astype(state_gla.dtype)
    ret_state_prompt = jnp.stack(ret_p).astype(state_ret.dtype)
    gla_state_sample = jnp.stack(gla_s).astype(state_gla.dtype)
    ret_state_sample = jnp.stack(ret_s).astype(state_ret.dtype)
    return (y_prompt, y_sample, gla_state_prompt, ret_state_prompt, gla_state_sample, ret_state_sample)
```

```cpp
#include <hip/hip_runtime.h>
#include <cstdio>
#include <cstdint>

#ifndef MK_ONE_LAUNCH
#define MK_ONE_LAUNCH 0
#endif

namespace pg8 {
#define PG8_LAS __attribute__((address_space(3)))
typedef unsigned short bf16_t;
typedef short bf16x8 __attribute__((ext_vector_type(8)));
typedef float f32x4 __attribute__((ext_vector_type(4)));
typedef unsigned u32x4 __attribute__((ext_vector_type(4)));
constexpr int BM = 256, BK = 64, HALF = 128, HTB = HALF * BK * 2, STAGE_BYTES = 8 * HTB, NXCD = 8, WGM = 8;

__host__ __device__ __forceinline__ int lds_byte(int r, int c) { const int st = (r >> 4) * 2 + (c >> 5), rr = r & 15, cc = c & 31, ob = rr * 64 + cc * 2; return st * 1024 + (ob ^ (((ob >> 9) & 1) << 5)); }
__host__ __device__ __forceinline__ void stage_rc(int b, int& R, int& C) { const int st = b / 1024, sb = b % 1024, swz = sb ^ (((sb >> 9) & 1) << 5); R = (st >> 1) * 16 + swz / 64; C = (st & 1) * 32 + (swz % 64) / 2; }
__host__ __device__ __forceinline__ int perm32(int rho) { const int n = rho >> 4, i = rho & 15; return 8 * (i >> 2) + 4 * n + (i & 3); }

struct Unit { int pm, pn; };
struct Gemm { const bf16_t* A; const bf16_t* Bt; int M, N, K; };

struct StaticOrder {
    int nM, nN, nwg, G, c;
    __host__ __device__ void init(int M, int N, int G_, int c_) { nM = M / BM; nN = N / BM; nwg = nM * nN; G = G_; c = c_; }
    __host__ __device__ bool next(int i, Unit& u) const {
        const long L = (long)i * G + c; if (L >= nwg) return false;
        int wgid = (int)L; { const int q = nwg / NXCD, r = nwg % NXCD, xcd = wgid % NXCD, off = wgid / NXCD; wgid = (xcd < r ? xcd * (q + 1) : r * (q + 1) + (xcd - r) * q) + off; }
        const int nig = WGM * nN, gid = wgid / nig, fm = gid * WGM, gsz = (nM - fm) < WGM ? (nM - fm) : WGM;
        u.pm = fm + ((wgid % nig) % gsz); u.pn = (wgid % nig) / gsz; return true;
    }
    __device__ __forceinline__ void a_ready(const Unit&) const {}
    __device__ __forceinline__ void done(const Unit&) const {}
};

__device__ __forceinline__ unsigned cvt_pk_bf16(float lo, float hi) { unsigned r; asm volatile("v_cvt_pk_bf16_f32 %0, %1, %2" : "=v"(r) : "v"(lo), "v"(hi)); return r; }

struct EpiBf16 {
    static constexpr bool PERM = true, AFTER_DRAIN = false;
    bf16_t* O; int ldc;
    __device__ __forceinline__ void operator()(const f32x4 (&acc)[2][2][4][2], const Unit& u, int wr, int wc, int fr, int fq) const {
        const int row0 = u.pm * BM + wr * 64 + fr; const int col0 = u.pn * BM + wc * 32 + 8 * fq;
#pragma unroll
        for (int ai = 0; ai < 2; ++ai)
#pragma unroll
            for (int m = 0; m < 4; ++m) { bf16_t* rowp = O + (size_t)(row0 + ai * HALF + m * 16) * ldc + col0;
#pragma unroll
                for (int bj = 0; bj < 2; ++bj) { const f32x4 v0 = acc[ai][bj][m][0], v1 = acc[ai][bj][m][1];
                    u32x4 w; w.x = cvt_pk_bf16(v0[0], v0[1]); w.y = cvt_pk_bf16(v0[2], v0[3]); w.z = cvt_pk_bf16(v1[0], v1[1]); w.w = cvt_pk_bf16(v1[2], v1[3]);
                    *(u32x4*)(rowp + bj * HALF) = w; } }
    }
};
struct EpiResid {
    static constexpr bool PERM = false, AFTER_DRAIN = false;
    const float* base0; float* out0; const float* base1; float* out1; int ldc; int MP;
    __device__ __forceinline__ void operator()(const f32x4 (&acc)[2][2][4][2], const Unit& u, int wr, int wc, int fr, int fq) const {
        const int row0 = u.pm * BM + wr * 64 + fr, col0 = u.pn * BM + wc * 32 + 4 * fq;
        const bool tail = (u.pm * BM >= MP);
#pragma unroll
        for (int ai = 0; ai < 2; ++ai) {
            if (tail && ai == 1) continue;
#pragma unroll
            for (int m = 0; m < 4; ++m) {
                const int row = row0 + ai * HALF + m * 16;
                const float* bp = tail ? base1 + (size_t)(row - MP) * ldc + col0 : base0 + (size_t)row * ldc + col0;
                float* op = tail ? out1 + (size_t)(row - MP) * ldc + col0 : out0 + (size_t)row * ldc + col0;
#pragma unroll
                for (int bj = 0; bj < 2; ++bj)
#pragma unroll
                    for (int n = 0; n < 2; ++n) { const f32x4 b = *(const f32x4*)(bp + bj * HALF + n * 16); *(f32x4*)(op + bj * HALF + n * 16) = acc[ai][bj][m][n] + b; }
            }
        }
    }
};

template <class Epi, class Sched>
__device__ __forceinline__ void gemm_phase(PG8_LAS unsigned char* lds, const Gemm g, const Sched& S, const Epi& E) {
    const int tid = threadIdx.x, wid = __builtin_amdgcn_readfirstlane(tid >> 6), lane = tid & 63, wr = wid >> 2, wc = wid & 3, fr = lane & 15, fq = lane >> 4;
    const int K = g.K, nt = K / BK;
    unsigned voffA[2], voffB[2];
#pragma unroll
    for (int i = 0; i < 2; ++i) { int R, C; stage_rc(tid * 16 + i * 8192, R, C); const int Rb = Epi::PERM ? ((R & ~31) + perm32(R & 31)) : R;
        voffA[i] = (unsigned)(R * K + C) * 2u; voffB[i] = (unsigned)(Rb * K + C) * 2u; }
    const size_t kstep = (size_t)(BK * 2);
    const size_t hstep = (size_t)HALF * K * 2;
    const size_t tstep = 2 * hstep;
    const unsigned ldsw = (unsigned)wid * 1024u;
    const int aoff = lds_byte(wr * 64 + fr, fq * 8), boff = lds_byte(wc * 32 + fr, fq * 8);
#define PG8_SA(b, h) (((b) * 2 + (h)) * HTB)
#define PG8_SB(b, h) ((4 + (b) * 2 + (h)) * HTB)
#define PG8_STAGE(bufoff, gbase, voff) do { _Pragma("unroll") for (int _i = 0; _i < 2; ++_i) \
        __builtin_amdgcn_global_load_lds((const unsigned*)((const char*)(gbase) + (voff)[_i]), (PG8_LAS unsigned*)(lds + (bufoff) + ldsw + _i * 8192), 16, 0, 0); } while (0)
#define PG8_LDA(dst, b, h) do { _Pragma("unroll") for (int m = 0; m < 4; ++m) _Pragma("unroll") for (int k = 0; k < 2; ++k) dst[m][k] = *(const PG8_LAS bf16x8*)(lds + PG8_SA(b, h) + aoff + m * 2048 + k * 1024); } while (0)
#define PG8_LDB(dst, b, h) do { _Pragma("unroll") for (int n = 0; n < 2; ++n) _Pragma("unroll") for (int k = 0; k < 2; ++k) dst[n][k] = *(const PG8_LAS bf16x8*)(lds + PG8_SB(b, h) + boff + n * 2048 + k * 1024); } while (0)
#define PG8_MMA(ai, bj, At, Bt) do { __builtin_amdgcn_s_setprio(1); _Pragma("unroll") for (int m = 0; m < 4; ++m) _Pragma("unroll") for (int n = 0; n < 2; ++n) _Pragma("unroll") for (int k = 0; k < 2; ++k) \
        acc[ai][bj][m][n] = __builtin_amdgcn_mfma_f32_16x16x32_bf16(Bt[n][k], At[m][k], acc[ai][bj][m][n], 0, 0, 0); __builtin_amdgcn_s_setprio(0); } while (0)
#define PG8_WAIT_V(n) asm volatile("s_waitcnt vmcnt(" #n ")" ::: "memory")
#define PG8_WAIT_L(n) asm volatile("s_waitcnt lgkmcnt(" #n ")" ::: "memory")
#define PG8_BAR __builtin_amdgcn_s_barrier()
#define PG8_SCHED __builtin_amdgcn_sched_barrier(0)
    Unit cur, nxt; int ui = 0;
    if (!S.next(0, cur)) return;
    f32x4 acc[2][2][4][2];
#pragma unroll
    for (int a = 0; a < 2; ++a)
#pragma unroll
        for (int b = 0; b < 2; ++b)
#pragma unroll
            for (int m = 0; m < 4; ++m)
#pragma unroll
                for (int n = 0; n < 2; ++n) acc[a][b][m][n] = (f32x4){0.f, 0.f, 0.f, 0.f};
    bf16x8 At[4][2], B0[2][2], B1[2][2];
    const char* cA = (const char*)g.A + (size_t)cur.pm * tstep; const char* cB = (const char*)g.Bt + (size_t)cur.pn * tstep;
    S.a_ready(cur);
    PG8_STAGE(PG8_SB(0, 0), cB, voffB); PG8_STAGE(PG8_SB(0, 1), cB + hstep, voffB); PG8_STAGE(PG8_SA(0, 0), cA, voffA); PG8_STAGE(PG8_SA(0, 1), cA + hstep, voffA);
    if (wr == 1) PG8_BAR;
    PG8_WAIT_V(2); PG8_BAR;
    PG8_STAGE(PG8_SB(1, 0), cB + kstep, voffB); PG8_STAGE(PG8_SA(1, 0), cA + kstep, voffA); PG8_STAGE(PG8_SB(1, 1), cB + hstep + kstep, voffB);
    PG8_WAIT_V(6); PG8_BAR;
    for (;;) {
        const bool has_next = S.next(ui + 1, nxt);
        const char* nA = has_next ? (const char*)g.A + (size_t)nxt.pm * tstep : cA; const char* nB = has_next ? (const char*)g.Bt + (size_t)nxt.pn * tstep : cB;
        for (int t = 0; t < nt; t += 2) {
            const bool last = (t == nt - 2);
            const char* a1 = cA + (size_t)(t + 1) * kstep;
            const char* a2 = last ? nA : cA + (size_t)(t + 2) * kstep; const char* b2 = last ? nB : cB + (size_t)(t + 2) * kstep;
            const char* a3 = a2 + kstep; const char* b3 = b2 + kstep;
            if (last && has_next) S.a_ready(nxt);
            PG8_LDB(B0, 0, 0); PG8_LDB(B1, 0, 1); PG8_SCHED; PG8_LDA(At, 0, 0); PG8_STAGE(PG8_SA(1, 1), a1 + hstep, voffA);
            PG8_WAIT_V(8); PG8_WAIT_L(0); PG8_BAR; PG8_MMA(0, 0, At, B0); PG8_MMA(0, 1, At, B1); PG8_BAR; PG8_SCHED;
            PG8_LDA(At, 0, 1); PG8_STAGE(PG8_SB(0, 0), b2, voffB); PG8_STAGE(PG8_SB(0, 1), b2 + hstep, voffB); PG8_STAGE(PG8_SA(0, 0), a2, voffA);
            PG8_WAIT_V(8); PG8_WAIT_L(0); PG8_BAR; PG8_MMA(1, 0, At, B0); PG8_MMA(1, 1, At, B1); PG8_BAR; PG8_SCHED;
            PG8_LDB(B0, 1, 0); PG8_LDB(B1, 1, 1); PG8_SCHED; PG8_LDA(At, 1, 0); PG8_STAGE(PG8_SA(0, 1), a2 + hstep, voffA);
            PG8_WAIT_V(8); PG8_WAIT_L(0); PG8_BAR; PG8_MMA(0, 0, At, B0); PG8_MMA(0, 1, At, B1); PG8_BAR; PG8_SCHED;
            PG8_LDA(At, 1, 1); PG8_STAGE(PG8_SB(1, 0), b3, voffB); PG8_STAGE(PG8_SB(1, 1), b3 + hstep, voffB); PG8_STAGE(PG8_SA(1, 0), a3, voffA);
            PG8_WAIT_V(8); PG8_WAIT_L(0); PG8_BAR; PG8_MMA(1, 0, At, B0); PG8_MMA(1, 1, At, B1); PG8_BAR; PG8_SCHED;
        }
        if (wr == 0) PG8_BAR;
        if constexpr (!Epi::AFTER_DRAIN) { E(acc, cur, wr, wc, fr, fq); S.done(cur); }
        if (!has_next) break;
#pragma unroll
        for (int a = 0; a < 2; ++a)
#pragma unroll
            for (int b = 0; b < 2; ++b)
#pragma unroll
                for (int m = 0; m < 4; ++m)
#pragma unroll
                    for (int n = 0; n < 2; ++n) acc[a][b][m][n] = (f32x4){0.f, 0.f, 0.f, 0.f};
        cur = nxt; cA = nA; cB = nB; ++ui;
        if (wr == 1) PG8_BAR;
    }
    PG8_WAIT_V(0);
    PG8_BAR;
#undef PG8_SA
#undef PG8_SB
#undef PG8_STAGE
#undef PG8_LDA
#undef PG8_LDB
#undef PG8_MMA
#undef PG8_WAIT_V
#undef PG8_WAIT_L
#undef PG8_BAR
#undef PG8_SCHED
}
}

constexpr int NWAVES = 8;
constexpr int D = 1024, BATCH = 8, SEQ = 2048, DEPTH = 2, DEC = 128;
constexpr int MP = BATCH * SEQ;
constexpr int MROWS = MP + DEC;
constexpr int MPAD = 16640;
constexpr int NIN = 3088, NINP = 3328;
constexpr int C_GQ = 0, C_GK = 256, C_GV = 512, C_GG = 1024, C_LR = 1536, C_RQ = 1552, C_RK = 1808, C_RV = 2064, C_RG = 2576;
constexpr int NPOS = SEQ + 1;
constexpr float EPS = 1e-6f, GN_EPS = 1e-5f;

constexpr size_t O_Y = 0, O_YS = 16777216, O_GP = 16908288, O_RP = 17432576, O_GS = 17956864, O_RS = 26345472;

constexpr size_t MiB = 1u << 20;
constexpr size_t WS_CTL = 0, CTL_ZERO_BYTES = 1 * MiB;
constexpr size_t WS_WIN = 2 * MiB;
constexpr size_t WS_WOUT = 16 * MiB;
constexpr size_t WS_ROPE = 20 * MiB;
constexpr size_t WS_H = 24 * MiB;
constexpr size_t WS_MIX = 60 * MiB;
constexpr size_t WS_Z = 96 * MiB;
constexpr size_t WS_XS = 204 * MiB;
constexpr size_t WS_END = 256 * MiB;
constexpr int CW_BAR = 4096;

constexpr int LDS_BYTES = 163840;
constexpr int RING_OFF = 0, RING_BYTES = 131072;
constexpr int MISC_OFF = 163840 - 256;

#define GAS __attribute__((address_space(1)))
#define LAS __attribute__((address_space(3)))
typedef unsigned short bf16;
typedef unsigned v4u __attribute__((ext_vector_type(4)));
typedef unsigned v2u __attribute__((ext_vector_type(2)));
typedef float f32x4 __attribute__((ext_vector_type(4)));
#define LDS_WAIT() asm volatile("s_waitcnt lgkmcnt(0)" ::: "memory")
#define VM_WAIT() asm volatile("s_waitcnt vmcnt(0)" ::: "memory")
__device__ __forceinline__ unsigned f2bf(float f) { unsigned u = __builtin_bit_cast(unsigned, f); return (u + 0x7fffu + ((u >> 16) & 1u)) >> 16; }
__device__ __forceinline__ unsigned pk2(float lo, float hi) { return f2bf(lo) | (f2bf(hi) << 16); }
__device__ __forceinline__ float bf2f(unsigned short b) { return __builtin_bit_cast(float, ((unsigned)b) << 16); }
__device__ __forceinline__ float bflo(unsigned w) { return __builtin_bit_cast(float, w << 16); }
__device__ __forceinline__ float bfhi(unsigned w) { return __builtin_bit_cast(float, w & 0xffff0000u); }

#define XB_TMO      128
#define XB_XCNT(j)  (256  + 64 * (j))
#define XB_XSUB(j)  (1280 + 64 * (j))
#define XB_XGEN(j)  (2304 + 64 * (j))
#define XB_TOP      3328
#define XB_TOPGEN   3392
#define XCD_BAR_WORDS 3456
#define XB_SPIN_CAP (1u << 18)
__device__ __forceinline__ unsigned xb_ld(unsigned* p)              { return __hip_atomic_load(p, __ATOMIC_RELAXED, __HIP_MEMORY_SCOPE_AGENT); }
__device__ __forceinline__ unsigned xb_add(unsigned* p, unsigned v) { return __hip_atomic_fetch_add(p, v, __ATOMIC_RELAXED, __HIP_MEMORY_SCOPE_AGENT); }
__device__ __forceinline__ unsigned xb_xcc_id() { return (unsigned)__builtin_amdgcn_s_getreg((3 << 11) | 20) & 0xFu; }
#define XB_SPIN(cond, bar) do { unsigned _sp = 0; while (cond) { __builtin_amdgcn_s_sleep(1); \
    if ((++_sp & 255u) == 0u) { if (xb_ld(&(bar)[XB_TMO])) break; if (_sp > XB_SPIN_CAP) { atomicAdd(&(bar)[XB_TMO], 1u); break; } } } } while (0)
struct XcdBarrier { unsigned* bar; unsigned x; volatile LAS unsigned* st; };
__device__ __forceinline__ XcdBarrier xcd_barrier_post(unsigned* bar, volatile LAS unsigned* st) {
    XcdBarrier b; b.bar = bar; b.x = xb_xcc_id(); b.st = st;
    if (threadIdx.x == 0) (void)xb_add(&bar[XB_XCNT(b.x)], 1u);
    return b;
}
__device__ __forceinline__ void xcd_barrier_complete(unsigned* bar, unsigned x, unsigned& nloc, unsigned& nx) {
    const unsigned G = gridDim.x * gridDim.y * gridDim.z;
    unsigned sum, cnt, mine, sp = 0u;
    for (;;) {
        sum = 0u; cnt = 0u; mine = 0u;
#pragma unroll
        for (unsigned j = 0; j < 16; ++j) { const unsigned c = xb_ld(&bar[XB_XCNT(j)]); sum += c; cnt += (c > 0u) ? 1u : 0u; mine = (j == x) ? c : mine; }
        if (sum == G) break;
        __builtin_amdgcn_s_sleep(1);
        if ((++sp & 255u) == 0u) { if (xb_ld(&bar[XB_TMO])) break; if (sp > XB_SPIN_CAP) { atomicAdd(&bar[XB_TMO], 1u); break; } }
    }
    nloc = mine > 0u ? mine : 1u; nx = cnt > 0u ? cnt : 1u;
}
__device__ __forceinline__ void xcd_barrier(const XcdBarrier& b) {
    asm volatile("s_waitcnt vmcnt(0)" ::: "memory");
    __syncthreads();
    if (threadIdx.x == 0) {
        unsigned* bar = b.bar;
        __builtin_amdgcn_s_waitcnt(0);
        unsigned nloc = b.st[0], nx = b.st[1];
        if (nloc == 0u) { xcd_barrier_complete(bar, b.x, nloc, nx); b.st[0] = nloc; b.st[1] = nx; }
        const unsigned old = xb_add(&bar[XB_XSUB(b.x)], 1u);
        const unsigned gen = old / nloc;
        if (old + 1u == (gen + 1u) * nloc) {
            __builtin_amdgcn_fence(__ATOMIC_RELEASE, "agent");
            asm volatile("s_waitcnt vmcnt(0)" ::: "memory");
            const unsigned og = xb_add(&bar[XB_TOP], 1u);
            const unsigned tg = og / nx;
            if (og + 1u == (tg + 1u) * nx) xb_add(&bar[XB_TOPGEN], 1u);
            else XB_SPIN(xb_ld(&bar[XB_TOPGEN]) == tg, bar);
            __builtin_amdgcn_fence(__ATOMIC_ACQUIRE, "agent");
            xb_add(&bar[XB_XGEN(b.x)], 1u);
            asm volatile("s_waitcnt vmcnt(0)" ::: "memory");
        } else {
            XB_SPIN(xb_ld(&bar[XB_XGEN(b.x)]) == gen, bar);
            __builtin_amdgcn_fence(__ATOMIC_ACQUIRE, "agent");
            asm volatile("s_waitcnt vmcnt(0)" ::: "memory");
        }
    }
    __syncthreads();
}

struct Args {
    const float* x_prompt; const float* x_sample; const float* state_gla; const float* state_ret; const float* norm_w; const float* w_in;
    const float* gla_w2; const float* gla_b; const float* gla_norm_w; const float* ret_norm_w; const float* ret_norm_b; const float* w_out; const float* final_norm_w;
    float* out; unsigned char* ws; int ph_lo, ph_hi;
};
struct Frame {
    LAS unsigned char* lds; int tid, lane, wave, vcu, G;
};

__device__ __forceinline__ float wave_sum(float v) {
#pragma unroll
    for (int o = 1; o < 64; o <<= 1) v += __shfl_xor(v, o);
    return v;
}

__device__ __forceinline__ void p0_transpose_item(const float* W, int K, int N, bf16* WT, LAS float* scr, int item, int nblk, int lane, int s0a, int s0b, int s1a, int s1b) {
    const int kb = item / nblk, nb = item % nblk, k0 = 64 * kb, n0 = 32 * nb;
    const int ncol = n0 + (lane & 31);
    const float sc = ((ncol >= s0a && ncol < s0b) || (ncol >= s1a && ncol < s1b)) ? 0.125f : 1.0f;
#pragma unroll 8
    for (int i = 0; i < 32; ++i) { const int kk = 2 * i + (lane >> 5); scr[kk * 33 + (lane & 31)] = (ncol < N) ? W[(size_t)(k0 + kk) * N + ncol] * sc : 0.f; }
    LDS_WAIT(); asm volatile("" ::: "memory");
    const int c = lane & 7;
#pragma unroll
    for (int j = 0; j < 4; ++j) { const int n = (lane >> 3) + 8 * j; const LAS float* s = scr + (8 * c) * 33 + n;
        v4u o; o.x = pk2(s[0 * 33], s[1 * 33]); o.y = pk2(s[2 * 33], s[3 * 33]); o.z = pk2(s[4 * 33], s[5 * 33]); o.w = pk2(s[6 * 33], s[7 * 33]);
        *(GAS v4u*)(WT + (size_t)(n0 + n) * K + k0 + 8 * c) = o; }
    LDS_WAIT(); asm volatile("" ::: "memory");
}
__device__ __forceinline__ void rms_row_to_bf16(int lane, const float* xrow, const float* w, bf16* orow) {
    const GAS f32x4* xr = (const GAS f32x4*)xrow + lane; const GAS f32x4* wr = (const GAS f32x4*)w + lane;
    f32x4 v[4]; float s2 = 0.f;
#pragma unroll
    for (int j = 0; j < 4; ++j) { v[j] = xr[64 * j]; s2 += (v[j].x * v[j].x + v[j].y * v[j].y) + (v[j].z * v[j].z + v[j].w * v[j].w); }
    const float rs = 1.f / sqrtf(wave_sum(s2) * (1.f / D) + EPS);
    GAS unsigned long long* o8 = (GAS unsigned long long*)orow + lane;
#pragma unroll
    for (int j = 0; j < 4; ++j) { const f32x4 ww = wr[64 * j]; o8[64 * j] = (unsigned long long)pk2(v[j].x * rs * ww.x, v[j].y * rs * ww.y) | ((unsigned long long)pk2(v[j].z * rs * ww.z, v[j].w * rs * ww.w) << 32); }
}
__device__ __forceinline__ void rms_row_to_f32(int lane, const float* xrow, const float* w, float* orow) {
    const GAS f32x4* xr = (const GAS f32x4*)xrow + lane; const GAS f32x4* wr = (const GAS f32x4*)w + lane;
    f32x4 v[4]; float s2 = 0.f;
#pragma unroll
    for (int j = 0; j < 4; ++j) { v[j] = xr[64 * j]; s2 += (v[j].x * v[j].x + v[j].y * v[j].y) + (v[j].z * v[j].z + v[j].w * v[j].w); }
    const float rs = 1.f / sqrtf(wave_sum(s2) * (1.f / D) + EPS);
    GAS f32x4* o = (GAS f32x4*)orow + lane;
#pragma unroll
    for (int j = 0; j < 4; ++j) { const f32x4 ww = wr[64 * j]; o[64 * j] = (f32x4){v[j].x * rs * ww.x, v[j].y * rs * ww.y, v[j].z * rs * ww.z, v[j].w * rs * ww.w}; }
}
__device__ __forceinline__ void rope_sincos(int pos, int i, float& c, float& s) {
    double inv = 1.0; const double r = 0.74989420933245582730;
    for (int k = 0; k < i; ++k) inv *= r;
    const double ang = (double)pos * inv;
    const double kq = __builtin_rint(ang * 0.63661977236758134308);
    double y = __builtin_fma(-kq, 1.57079632679489655800e+00, ang); y = __builtin_fma(-kq, 6.12323399573676603587e-17, y);
    const double y2 = y * y;
    double sp = -2.5052108385441718775e-08; sp = sp * y2 + 2.7557319223985890653e-06; sp = sp * y2 - 1.9841269841269841253e-04; sp = sp * y2 + 8.3333333333333332177e-03; sp = sp * y2 - 1.6666666666666665741e-01; sp = y + y * y2 * sp;
    double cp = 2.0876756987868098979e-09; cp = cp * y2 - 2.7557319223985888276e-07; cp = cp * y2 + 2.4801587301587301566e-05; cp = cp * y2 - 1.3888888888888889419e-03; cp = cp * y2 + 4.1666666666666664354e-02; cp = cp * y2 - 0.5; cp = 1.0 + y2 * cp;
    const int q = ((int)(long long)kq) & 3;
    const double sv = (q == 0) ? sp : (q == 1) ? cp : (q == 2) ? -sp : -cp;
    const double cv = (q == 0) ? cp : (q == 1) ? -sp : (q == 2) ? -cp : sp;
    c = (float)cv; s = (float)sv;
}
__device__ __forceinline__ void p0_prologue(const Frame& F, const Args& a) {
    LAS float* scr = (LAS float*)(F.lds + RING_OFF + F.wave * 16384);
    const int gw = F.vcu * NWAVES + F.wave, NGW = F.G * NWAVES;
    constexpr int NB_IN = NINP / 32, I_IN = (D / 64) * NB_IN, NB_O = D / 32, I_O = (D / 64) * NB_O;
    constexpr int NITEMS = 2 * I_IN + 2 * I_O;
    bf16* win = (bf16*)(a.ws + WS_WIN); bf16* wout = (bf16*)(a.ws + WS_WOUT);
    for (int it = gw; it < NITEMS; it += NGW) {
        int r = it;
        if (r < 2 * I_IN) { const int l = r / I_IN; r -= l * I_IN; p0_transpose_item(a.w_in + (size_t)l * D * NIN, D, NIN, win + (size_t)l * NINP * D, scr, r, NB_IN, F.lane, C_GQ, C_GQ + 256, C_RK, C_RK + 256); continue; }
        r -= 2 * I_IN;
        { const int l = r / I_O; r -= l * I_O; p0_transpose_item(a.w_out + (size_t)l * D * D, D, D, wout + (size_t)l * D * D, scr, r, NB_O, F.lane, 0, 0, 0, 0); }
    }
    float* rope = (float*)(a.ws + WS_ROPE);
    for (int e = (F.vcu * NWAVES * 64 + F.tid); e < NPOS * 32; e += F.G * NWAVES * 64) {
        const int p = e >> 5, i = e & 31; float c, s; rope_sincos(p == SEQ ? 16384 : p, i, c, s);
        rope[p * 64 + i] = c; rope[p * 64 + 32 + i] = s;
    }
    bf16* H = (bf16*)(a.ws + WS_H);
    for (int m = gw; m < MPAD; m += NGW) {
        if (m < MP) rms_row_to_bf16(F.lane, a.x_prompt + (size_t)m * D, a.norm_w, H + (size_t)m * D);
        else if (m < MROWS) rms_row_to_bf16(F.lane, a.x_sample + (size_t)(m - MP) * D, a.norm_w, H + (size_t)m * D);
        else { GAS unsigned long long* o8 = (GAS unsigned long long*)(H + (size_t)m * D) + F.lane;
#pragma unroll
            for (int j = 0; j < 4; ++j) o8[64 * j] = 0ull; }
    }
}

__device__ __forceinline__ void p4_norm(const Frame& F, const Args& a, int l) {
    const int gw = F.vcu * NWAVES + F.wave, NGW = F.G * NWAVES;
    bf16* H = (bf16*)(a.ws + WS_H); float* XS = (float*)(a.ws + WS_XS);
    for (int m = gw; m < MROWS; m += NGW) {
        const float* src = (m < MP) ? a.out + O_Y + (size_t)m * D : XS + (size_t)(m - MP) * D;
        if (l == 0) rms_row_to_bf16(F.lane, src, a.norm_w + D, H + (size_t)m * D);
        else rms_row_to_f32(F.lane, src, a.final_norm_w, (m < MP) ? a.out + O_Y + (size_t)m * D : a.out + O_YS + (size_t)(m - MP) * D);
    }
}

__device__ __forceinline__ float log_sigmoid(float x) { return fminf(x, 0.f) - log1pf(expf(-fabsf(x))); }
__device__ __forceinline__ float silu(float x) { return x / (1.f + expf(-x)); }
__device__ __forceinline__ void p2_item(const Frame& F, const Args& a, int l, int row0, int ntok, int pos0row, int hd, const float* s_in, float* s_out) {
    LAS float* qs = (LAS float*)(F.lds); LAS float* ks = qs + 2048; LAS float* dc = ks + 2048; LAS float* ob = dc + 2048; LAS float* st = ob + 4096;
    const bf16* Z = (const bf16*)(a.ws + WS_Z); bf16* MIX = (bf16*)(a.ws + WS_MIX); const float* rope = (const float*)(a.ws + WS_ROPE);
    const bool gla = hd < 4; const int hh = hd & 3;
    const int cq = gla ? C_GQ + 64 * hh : C_RQ + 64 * hh, ck = gla ? C_GK + 64 * hh : C_RK + 64 * hh, cv = gla ? C_GV + 128 * hh : C_RV + 128 * hh, cg = gla ? C_GG + 128 * hh : C_RG + 128 * hh;
    const float lgam = logf(1.0f - exp2f(-5.0f - (float)hh)), gam = 1.0f - exp2f(-5.0f - (float)hh);
    const int tid = F.tid;
    float S[64];
    if (tid < 128) {
#pragma unroll
        for (int f = 0; f < 64; ++f) S[f] = s_in ? s_in[f * 128 + tid] : 0.f;
    }
    (void)lgam;
    for (int t0 = 0; t0 < ntok; t0 += 32) {
        const int nb = (ntok - t0) < 32 ? (ntok - t0) : 32;
        { const int t = tid >> 4, f0 = (tid & 15) * 4;
          if (t < nb) {
            const bf16* zr = Z + (size_t)(row0 + t0 + t) * NINP;
            if (gla) {
                float pre[4];
#pragma unroll
                for (int j = 0; j < 4; ++j) pre[j] = a.gla_b[l * 256 + hh * 64 + f0 + j];
                for (int r = 0; r < 16; ++r) { const float g = bf2f(zr[C_LR + r]);
#pragma unroll
                    for (int j = 0; j < 4; ++j) pre[j] += g * a.gla_w2[(size_t)l * 16 * 256 + r * 256 + hh * 64 + f0 + j]; }
#pragma unroll
                for (int j = 0; j < 4; ++j) { dc[t * 64 + f0 + j] = expf(log_sigmoid(pre[j]) * (1.f / 16.f)); qs[t * 64 + f0 + j] = bf2f(zr[cq + f0 + j]); ks[t * 64 + f0 + j] = bf2f(zr[ck + f0 + j]); }
            } else {
                const int p = pos0row + ((pos0row == SEQ) ? 0 : (t0 + t));
#pragma unroll
                for (int j = 0; j < 4; ++j) { const int f = f0 + j, i = f & 31; const float c = rope[p * 64 + i], s = rope[p * 64 + 32 + i];
                    const float q1 = bf2f(zr[cq + i]), q2 = bf2f(zr[cq + 32 + i]), k1 = bf2f(zr[ck + i]), k2 = bf2f(zr[ck + 32 + i]);
                    qs[t * 64 + f] = (f < 32) ? q1 * c - q2 * s : q1 * s + q2 * c; ks[t * 64 + f] = (f < 32) ? k1 * c - k2 * s : k1 * s + k2 * c; dc[t * 64 + f] = gam; }
            }
          } }
        __syncthreads();
        if (tid < 128) {
            for (int t = 0; t < nb; ++t) {
                const float v = bf2f(Z[(size_t)(row0 + t0 + t) * NINP + cv + tid]);
                float o = 0.f;
#pragma unroll
                for (int f = 0; f < 64; ++f) { S[f] = dc[t * 64 + f] * S[f] + ks[t * 64 + f] * v; o += qs[t * 64 + f] * S[f]; }
                ob[t * 128 + tid] = o;
            }
        }
        __syncthreads();
        if (tid < nb) { float s = 0.f, s2 = 0.f;
            for (int d = 0; d < 128; ++d) { const float o = ob[tid * 128 + ((d + tid) & 127)]; s += o; s2 += o * o; }
            if (gla) { st[tid * 2] = 0.f; st[tid * 2 + 1] = 1.f / sqrtf(s2 * (1.f / 128.f) + EPS); }
            else { const float mu = s * (1.f / 128.f); float var = 0.f;
                for (int d = 0; d < 128; ++d) { const float o = ob[tid * 128 + ((d + tid) & 127)] - mu; var += o * o; }
                st[tid * 2] = mu; st[tid * 2 + 1] = 1.f / sqrtf(var * (1.f / 128.f) + GN_EPS); } }
        __syncthreads();
        for (int e = tid; e < nb * 128; e += 512) { const int t = e >> 7, d = e & 127;
            const float o = (ob[e] - st[t * 2]) * st[t * 2 + 1];
            const float g = bf2f(Z[(size_t)(row0 + t0 + t) * NINP + cg + d]);
            float y;
            if (gla) y = o * a.gla_norm_w[l * 128 + d] * silu(g);
            else y = (o * a.ret_norm_w[l * 512 + hh * 128 + d] + a.ret_norm_b[l * 512 + hh * 128 + d]) * silu(g);
            MIX[(size_t)(row0 + t0 + t) * D + hd * 128 + d] = (bf16)f2bf(y); }
        __syncthreads();
    }
    if (tid < 128) {
#pragma unroll
        for (int f = 0; f < 64; ++f) s_out[f * 128 + tid] = S[f];
    }
    __syncthreads();
}
__device__ __forceinline__ void p2_simple(const Frame& F, const Args& a, int l) {
    const int NIT = BATCH * 8 + DEC * 8;
    for (int it = F.vcu; it < NIT; it += F.G) {
        int row0, ntok, posrow, hd; const float* si; float* so;
        if (it < BATCH * 8) { const int b = it >> 3; hd = it & 7; const bool gla = hd < 4; const int hh = hd & 3;
            so = a.out + (gla ? O_GP : O_RP) + ((size_t)(l * BATCH + b) * 4 + hh) * 8192; si = nullptr; row0 = b * SEQ; ntok = SEQ; posrow = 0;
        } else { const int j = it - BATCH * 8, n = j >> 3; hd = j & 7; const bool gla = hd < 4; const int hh = hd & 3;
            si = (gla ? a.state_gla : a.state_ret) + ((size_t)(l * DEC + n) * 4 + hh) * 8192;
            so = a.out + (gla ? O_GS : O_RS) + ((size_t)(l * DEC + n) * 4 + hh) * 8192; row0 = MP + n; ntok = 1; posrow = SEQ;
        }
        p2_item(F, a, l, row0, ntok, posrow, hd, si, so);
    }
}

constexpr int N_PHASES = 9;
__global__ void __launch_bounds__(NWAVES * 64, 2) hymba_fwd(Args args) {
    extern __shared__ __attribute__((aligned(16))) unsigned char lds[];
    Frame F;
    F.lds = (LAS unsigned char*)lds;
    F.tid = threadIdx.x; F.lane = F.tid & 63; F.wave = __builtin_amdgcn_readfirstlane(F.tid >> 6);
    F.G = gridDim.x; { const int bx = blockIdx.x; F.vcu = (F.G % 8 == 0) ? (bx % 8) * (F.G / 8) + bx / 8 : bx; }
    volatile LAS unsigned* MISC = (volatile LAS unsigned*)(F.lds + MISC_OFF);
    if (F.tid < 64) MISC[F.tid] = 0u;
    __syncthreads();
    unsigned* ctl = (unsigned*)(args.ws + WS_CTL);
    XcdBarrier bar; bar.bar = ctl + CW_BAR; bar.x = 0; bar.st = nullptr;
    const int lo = args.ph_lo, hi = args.ph_hi;
    const bool multi = (hi - lo) > 1;
    if (multi) bar = xcd_barrier_post(ctl + CW_BAR, MISC + 8);
#define IN(k) (lo <= (k) && (k) < hi)
#define SEAM(k) do { if (IN(k) && IN((k) + 1)) xcd_barrier(bar); } while (0)

    if (IN(0)) { p0_prologue(F, args); SEAM(0); }
#pragma unroll
    for (int l = 0; l < DEPTH; ++l) {
        const int pb = 1 + 4 * l;
        if (IN(pb)) {
            pg8::Gemm g{(const bf16*)(args.ws + WS_H), (const bf16*)(args.ws + WS_WIN) + (size_t)l * NINP * D, MPAD, NINP, D};
            pg8::StaticOrder S; S.init(MPAD, NINP, F.G, (int)blockIdx.x);
            pg8::EpiBf16 E{(bf16*)(args.ws + WS_Z), NINP};
            pg8::gemm_phase<pg8::EpiBf16, pg8::StaticOrder>(F.lds + RING_OFF, g, S, E);
            SEAM(pb);
        }
        if (IN(pb + 1)) { p2_simple(F, args, l); SEAM(pb + 1); }
        if (IN(pb + 2)) {
            pg8::Gemm g{(const bf16*)(args.ws + WS_MIX), (const bf16*)(args.ws + WS_WOUT) + (size_t)l * D * D, MPAD, D, D};
            pg8::StaticOrder S; S.init(MPAD, D, F.G, (int)blockIdx.x);
            pg8::EpiResid E{l == 0 ? args.x_prompt : args.out + O_Y, args.out + O_Y, l == 0 ? args.x_sample : (const float*)(args.ws + WS_XS), (float*)(args.ws + WS_XS), D, MP};
            pg8::gemm_phase<pg8::EpiResid, pg8::StaticOrder>(F.lds + RING_OFF, g, S, E);
            SEAM(pb + 2);
        }
        if (IN(pb + 3)) { p4_norm(F, args, l); SEAM(pb + 3); }
    }
#undef IN
#undef SEAM
}

extern "C" void kernel_launch(void* const* d_in, const int* in_sizes, int n_in, void* d_out, int out_size, void* d_ws, size_t ws_size, hipStream_t stream) {
    static int grid = 0;
    if (grid == 0) {
        int dev = 0, cus = 0, per_cu = 0;
        if (n_in != 13 || ws_size < WS_END) { fprintf(stderr, "kernel_launch: unexpected n_in %d / ws %zu\n", n_in, ws_size); grid = -1; return; }
        if (hipGetDevice(&dev) != hipSuccess || hipDeviceGetAttribute(&cus, hipDeviceAttributeMultiprocessorCount, dev) != hipSuccess) { grid = -1; return; }
        if (hipFuncSetAttribute((const void*)hymba_fwd, hipFuncAttributeMaxDynamicSharedMemorySize, LDS_BYTES) != hipSuccess) { fprintf(stderr, "kernel_launch: hipFuncSetAttribute failed\n"); grid = -1; return; }
        if (hipOccupancyMaxActiveBlocksPerMultiprocessor(&per_cu, (const void*)hymba_fwd, NWAVES * 64, LDS_BYTES) != hipSuccess || per_cu < 1) { fprintf(stderr, "kernel_launch: occupancy query says %d\n", per_cu); per_cu = 1; }
        (void)hipGetLastError();
        grid = cus * 1;
    }
    if (grid < 0) return;
    (void)hipMemsetAsync((char*)d_ws + WS_CTL, 0, CTL_ZERO_BYTES, stream);
    Args a{};
    a.x_prompt = (const float*)d_in[0]; a.x_sample = (const float*)d_in[1]; a.state_gla = (const float*)d_in[2]; a.state_ret = (const float*)d_in[3];
    a.norm_w = (const float*)d_in[4]; a.w_in = (const float*)d_in[5]; a.gla_w2 = (const float*)d_in[6]; a.gla_b = (const float*)d_in[7];
    a.gla_norm_w = (const float*)d_in[8]; a.ret_norm_w = (const float*)d_in[9]; a.ret_norm_b = (const float*)d_in[10]; a.w_out = (const float*)d_in[11];
    a.final_norm_w = (const float*)d_in[12];
    a.out = (float*)d_out; a.ws = (unsigned char*)d_ws;
#if MK_ONE_LAUNCH
    a.ph_lo = 0; a.ph_hi = N_PHASES;
    hipLaunchKernelGGL(hymba_fwd, dim3(grid), dim3(NWAVES * 64), LDS_BYTES, stream, a);
#else
    for (int p = 0; p < N_PHASES; ++p) { a.ph_lo = p; a.ph_hi = p + 1; hipLaunchKernelGGL(hymba_fwd, dim3(grid), dim3(NWAVES * 64), LDS_BYTES, stream, a); }
#endif
}
```

```cpp
#include <hip/hip_runtime.h>
#include <cstdio>
#include <cstdint>

#ifndef MK_ONE_LAUNCH
#define MK_ONE_LAUNCH 1
#endif

namespace pg8 {
#define PG8_LAS __attribute__((address_space(3)))
typedef unsigned short bf16_t;
typedef short bf16x8 __attribute__((ext_vector_type(8)));
typedef float f32x4 __attribute__((ext_vector_type(4)));
typedef unsigned u32x4 __attribute__((ext_vector_type(4)));
constexpr int BM = 256, BK = 64, HALF = 128, HTB = HALF * BK * 2, STAGE_BYTES = 8 * HTB, NXCD = 8, WGM = 8;

__host__ __device__ __forceinline__ int lds_byte(int r, int c) { const int st = (r >> 4) * 2 + (c >> 5), rr = r & 15, cc = c & 31, ob = rr * 64 + cc * 2; return st * 1024 + (ob ^ (((ob >> 9) & 1) << 5)); }
__host__ __device__ __forceinline__ void stage_rc(int b, int& R, int& C) { const int st = b / 1024, sb = b % 1024, swz = sb ^ (((sb >> 9) & 1) << 5); R = (st >> 1) * 16 + swz / 64; C = (st & 1) * 32 + (swz % 64) / 2; }
__host__ __device__ __forceinline__ int perm32(int rho) { const int n = rho >> 4, i = rho & 15; return 8 * (i >> 2) + 4 * n + (i & 3); }

struct Unit { int pm, pn; };
struct Gemm { const bf16_t* A; const bf16_t* Bt; int M, N, K; };

struct StaticOrder {
    int nM, nN, nwg, G, c;
    __host__ __device__ void init(int M, int N, int G_, int c_) { nM = M / BM; nN = N / BM; nwg = nM * nN; G = G_; c = c_; }
    __host__ __device__ bool next(int i, Unit& u) const {
        const long L = (long)i * G + c; if (L >= nwg) return false;
        int wgid = (int)L; { const int q = nwg / NXCD, r = nwg % NXCD, xcd = wgid % NXCD, off = wgid / NXCD; wgid = (xcd < r ? xcd * (q + 1) : r * (q + 1) + (xcd - r) * q) + off; }
        const int nig = WGM * nN, gid = wgid / nig, fm = gid * WGM, gsz = (nM - fm) < WGM ? (nM - fm) : WGM;
        u.pm = fm + ((wgid % nig) % gsz); u.pn = (wgid % nig) / gsz; return true;
    }
    __device__ __forceinline__ void a_ready(const Unit&) const {}
    __device__ __forceinline__ void done(const Unit&) const {}
};

__device__ __forceinline__ unsigned cvt_pk_bf16(float lo, float hi) { unsigned r; asm volatile("v_cvt_pk_bf16_f32 %0, %1, %2" : "=v"(r) : "v"(lo), "v"(hi)); return r; }

struct EpiBf16 {
    static constexpr bool PERM = true, AFTER_DRAIN = false;
    bf16_t* O; int ldc;
    __device__ __forceinline__ void operator()(const f32x4 (&acc)[2][2][4][2], const Unit& u, int wr, int wc, int fr, int fq) const {
        const int row0 = u.pm * BM + wr * 64 + fr; const int col0 = u.pn * BM + wc * 32 + 8 * fq;
#pragma unroll
        for (int ai = 0; ai < 2; ++ai)
#pragma unroll
            for (int m = 0; m < 4; ++m) { bf16_t* rowp = O + (size_t)(row0 + ai * HALF + m * 16) * ldc + col0;
#pragma unroll
                for (int bj = 0; bj < 2; ++bj) { const f32x4 v0 = acc[ai][bj][m][0], v1 = acc[ai][bj][m][1];
                    u32x4 w; w.x = cvt_pk_bf16(v0[0], v0[1]); w.y = cvt_pk_bf16(v0[2], v0[3]); w.z = cvt_pk_bf16(v1[0], v1[1]); w.w = cvt_pk_bf16(v1[2], v1[3]);
                    *(u32x4*)(rowp + bj * HALF) = w; } }
    }
};
struct EpiResid {
    static constexpr bool PERM = false, AFTER_DRAIN = false;
    const float* base0; float* out0; const float* base1; float* out1; int ldc; int MP;
    __device__ __forceinline__ void operator()(const f32x4 (&acc)[2][2][4][2], const Unit& u, int wr, int wc, int fr, int fq) const {
        const int row0 = u.pm * BM + wr * 64 + fr, col0 = u.pn * BM + wc * 32 + 4 * fq;
        const bool tail = (u.pm * BM >= MP);
#pragma unroll
        for (int ai = 0; ai < 2; ++ai) {
            if (tail && ai == 1) continue;
#pragma unroll
            for (int m = 0; m < 4; ++m) {
                const int row = row0 + ai * HALF + m * 16;
                const float* bp = tail ? base1 + (size_t)(row - MP) * ldc + col0 : base0 + (size_t)row * ldc + col0;
                float* op = tail ? out1 + (size_t)(row - MP) * ldc + col0 : out0 + (size_t)row * ldc + col0;
#pragma unroll
                for (int bj = 0; bj < 2; ++bj)
#pragma unroll
                    for (int n = 0; n < 2; ++n) { const f32x4 b = *(const f32x4*)(bp + bj * HALF + n * 16); *(f32x4*)(op + bj * HALF + n * 16) = acc[ai][bj][m][n] + b; }
            }
        }
    }
};

template <class Epi, class Sched>
__device__ __forceinline__ void gemm_phase(PG8_LAS unsigned char* lds, const Gemm g, const Sched& S, const Epi& E) {
    const int tid = threadIdx.x, wid = __builtin_amdgcn_readfirstlane(tid >> 6), lane = tid & 63, wr = wid >> 2, wc = wid & 3, fr = lane & 15, fq = lane >> 4;
    const int K = g.K, nt = K / BK;
    unsigned voffA[2], voffB[2];
#pragma unroll
    for (int i = 0; i < 2; ++i) { int R, C; stage_rc(tid * 16 + i * 8192, R, C); const int Rb = Epi::PERM ? ((R & ~31) + perm32(R & 31)) : R;
        voffA[i] = (unsigned)(R * K + C) * 2u; voffB[i] = (unsigned)(Rb * K + C) * 2u; }
    const size_t kstep = (size_t)(BK * 2);
    const size_t hstep = (size_t)HALF * K * 2;
    const size_t tstep = 2 * hstep;
    const unsigned ldsw = (unsigned)wid * 1024u;
    const int aoff = lds_byte(wr * 64 + fr, fq * 8), boff = lds_byte(wc * 32 + fr, fq * 8);
#define PG8_SA(b, h) (((b) * 2 + (h)) * HTB)
#define PG8_SB(b, h) ((4 + (b) * 2 + (h)) * HTB)
#define PG8_STAGE(bufoff, gbase, voff) do { _Pragma("unroll") for (int _i = 0; _i < 2; ++_i) \
        __builtin_amdgcn_global_load_lds((const unsigned*)((const char*)(gbase) + (voff)[_i]), (PG8_LAS unsigned*)(lds + (bufoff) + ldsw + _i * 8192), 16, 0, 0); } while (0)
#define PG8_LDA(dst, b, h) do { _Pragma("unroll") for (int m = 0; m < 4; ++m) _Pragma("unroll") for (int k = 0; k < 2; ++k) dst[m][k] = *(const PG8_LAS bf16x8*)(lds + PG8_SA(b, h) + aoff + m * 2048 + k * 1024); } while (0)
#define PG8_LDB(dst, b, h) do { _Pragma("unroll") for (int n = 0; n < 2; ++n) _Pragma("unroll") for (int k = 0; k < 2; ++k) dst[n][k] = *(const PG8_LAS bf16x8*)(lds + PG8_SB(b, h) + boff + n * 2048 + k * 1024); } while (0)
#define PG8_MMA(ai, bj, At, Bt) do { __builtin_amdgcn_s_setprio(1); _Pragma("unroll") for (int m = 0; m < 4; ++m) _Pragma("unroll") for (int n = 0; n < 2; ++n) _Pragma("unroll") for (int k = 0; k < 2; ++k) \
        acc[ai][bj][m][n] = __builtin_amdgcn_mfma_f32_16x16x32_bf16(Bt[n][k], At[m][k], acc[ai][bj][m][n], 0, 0, 0); __builtin_amdgcn_s_setprio(0); } while (0)
#define PG8_WAIT_V(n) asm volatile("s_waitcnt vmcnt(" #n ")" ::: "memory")
#define PG8_WAIT_L(n) asm volatile("s_waitcnt lgkmcnt(" #n ")" ::: "memory")
#define PG8_BAR __builtin_amdgcn_s_barrier()
#define PG8_SCHED __builtin_amdgcn_sched_barrier(0)
    Unit cur, nxt; int ui = 0;
    if (!S.next(0, cur)) return;
    f32x4 acc[2][2][4][2];
#pragma unroll
    for (int a = 0; a < 2; ++a)
#pragma unroll
        for (int b = 0; b < 2; ++b)
#pragma unroll
            for (int m = 0; m < 4; ++m)
#pragma unroll
                for (int n = 0; n < 2; ++n) acc[a][b][m][n] = (f32x4){0.f, 0.f, 0.f, 0.f};
    bf16x8 At[4][2], B0[2][2], B1[2][2];
    const char* cA = (const char*)g.A + (size_t)cur.pm * tstep; const char* cB = (const char*)g.Bt + (size_t)cur.pn * tstep;
    S.a_ready(cur);
    PG8_STAGE(PG8_SB(0, 0), cB, voffB); PG8_STAGE(PG8_SB(0, 1), cB + hstep, voffB); PG8_STAGE(PG8_SA(0, 0), cA, voffA); PG8_STAGE(PG8_SA(0, 1), cA + hstep, voffA);
    if (wr == 1) PG8_BAR;
    PG8_WAIT_V(2); PG8_BAR;
    PG8_STAGE(PG8_SB(1, 0), cB + kstep, voffB); PG8_STAGE(PG8_SA(1, 0), cA + kstep, voffA); PG8_STAGE(PG8_SB(1, 1), cB + hstep + kstep, voffB);
    PG8_WAIT_V(6); PG8_BAR;
    for (;;) {
        const bool has_next = S.next(ui + 1, nxt);
        const char* nA = has_next ? (const char*)g.A + (size_t)nxt.pm * tstep : cA; const char* nB = has_next ? (const char*)g.Bt + (size_t)nxt.pn * tstep : cB;
        for (int t = 0; t < nt; t += 2) {
            const bool last = (t == nt - 2);
            const char* a1 = cA + (size_t)(t + 1) * kstep;
            const char* a2 = last ? nA : cA + (size_t)(t + 2) * kstep; const char* b2 = last ? nB : cB + (size_t)(t + 2) * kstep;
            const char* a3 = a2 + kstep; const char* b3 = b2 + kstep;
            if (last && has_next) S.a_ready(nxt);
            PG8_LDB(B0, 0, 0); PG8_LDB(B1, 0, 1); PG8_SCHED; PG8_LDA(At, 0, 0); PG8_STAGE(PG8_SA(1, 1), a1 + hstep, voffA);
            PG8_WAIT_V(8); PG8_WAIT_L(0); PG8_BAR; PG8_MMA(0, 0, At, B0); PG8_MMA(0, 1, At, B1); PG8_BAR; PG8_SCHED;
            PG8_LDA(At, 0, 1); PG8_STAGE(PG8_SB(0, 0), b2, voffB); PG8_STAGE(PG8_SB(0, 1), b2 + hstep, voffB); PG8_STAGE(PG8_SA(0, 0), a2, voffA);
            PG8_WAIT_V(8); PG8_WAIT_L(0); PG8_BAR; PG8_MMA(1, 0, At, B0); PG8_MMA(1, 1, At, B1); PG8_BAR; PG8_SCHED;
            PG8_LDB(B0, 1, 0); PG8_LDB(B1, 1, 1); PG8_SCHED; PG8_LDA(At, 1, 0); PG8_STAGE(PG8_SA(0, 1), a2 + hstep, voffA);
            PG8_WAIT_V(8); PG8_WAIT_L(0); PG8_BAR; PG8_MMA(0, 0, At, B0); PG8_MMA(0, 1, At, B1); PG8_BAR; PG8_SCHED;
            PG8_LDA(At, 1, 1); PG8_STAGE(PG8_SB(1, 0), b3, voffB); PG8_STAGE(PG8_SB(1, 1), b3 + hstep, voffB); PG8_STAGE(PG8_SA(1, 0), a3, voffA);
            PG8_WAIT_V(8); PG8_WAIT_L(0); PG8_BAR; PG8_MMA(1, 0, At, B0); PG8_MMA(1, 1, At, B1); PG8_BAR; PG8_SCHED;
        }
        if (wr == 0) PG8_BAR;
        if constexpr (!Epi::AFTER_DRAIN) { E(acc, cur, wr, wc, fr, fq); S.done(cur); }
        if (!has_next) break;
#pragma unroll
        for (int a = 0; a < 2; ++a)
#pragma unroll
            for (int b = 0; b < 2; ++b)
#pragma unroll
                for (int m = 0; m < 4; ++m)
#pragma unroll
                    for (int n = 0; n < 2; ++n) acc[a][b][m][n] = (f32x4){0.f, 0.f, 0.f, 0.f};
        cur = nxt; cA = nA; cB = nB; ++ui;
        if (wr == 1) PG8_BAR;
    }
    PG8_WAIT_V(0);
    PG8_BAR;
#undef PG8_SA
#undef PG8_SB
#undef PG8_STAGE
#undef PG8_LDA
#undef PG8_LDB
#undef PG8_MMA
#undef PG8_WAIT_V
#undef PG8_WAIT_L
#undef PG8_BAR
#undef PG8_SCHED
}
}

constexpr int NWAVES = 8;
constexpr int D = 1024, BATCH = 8, SEQ = 2048, DEPTH = 2, DEC = 128;
constexpr int MP = BATCH * SEQ;
constexpr int MROWS = MP + DEC;
constexpr int MPAD = 16640;
constexpr int NIN = 3088, NINP = 3328;
constexpr int C_GQ = 0, C_GK = 256, C_GV = 512, C_GG = 1024, C_LR = 1536, C_RQ = 1552, C_RK = 1808, C_RV = 2064, C_RG = 2576;
constexpr int NPOS = SEQ + 1;
constexpr float EPS = 1e-6f, GN_EPS = 1e-5f;

constexpr size_t O_Y = 0, O_YS = 16777216, O_GP = 16908288, O_RP = 17432576, O_GS = 17956864, O_RS = 26345472;

constexpr size_t MiB = 1u << 20;
constexpr size_t WS_CTL = 0, CTL_ZERO_BYTES = 1 * MiB;
constexpr size_t WS_WIN = 2 * MiB;
constexpr size_t WS_WOUT = 16 * MiB;
constexpr size_t WS_ROPE = 20 * MiB;
constexpr size_t WS_H = 24 * MiB;
constexpr size_t WS_MIX = 60 * MiB;
constexpr size_t WS_Z = 96 * MiB;
constexpr size_t WS_XS = 204 * MiB;
constexpr size_t WS_END = 256 * MiB;
constexpr int CW_BAR = 4096;

constexpr int LDS_BYTES = 163840;
constexpr int RING_OFF = 0, RING_BYTES = 131072;
constexpr int MISC_OFF = 163840 - 256;

#define GAS __attribute__((address_space(1)))
#define LAS __attribute__((address_space(3)))
typedef unsigned short bf16;
typedef unsigned v4u __attribute__((ext_vector_type(4)));
typedef unsigned v2u __attribute__((ext_vector_type(2)));
typedef float f32x4 __attribute__((ext_vector_type(4)));
#define LDS_WAIT() asm volatile("s_waitcnt lgkmcnt(0)" ::: "memory")
#define VM_WAIT() asm volatile("s_waitcnt vmcnt(0)" ::: "memory")
__device__ __forceinline__ unsigned f2bf(float f) { unsigned u = __builtin_bit_cast(unsigned, f); return (u + 0x7fffu + ((u >> 16) & 1u)) >> 16; }
__device__ __forceinline__ unsigned pk2(float lo, float hi) { return f2bf(lo) | (f2bf(hi) << 16); }
__device__ __forceinline__ float bf2f(unsigned short b) { return __builtin_bit_cast(float, ((unsigned)b) << 16); }
__device__ __forceinline__ float bflo(unsigned w) { return __builtin_bit_cast(float, w << 16); }
__device__ __forceinline__ float bfhi(unsigned w) { return __builtin_bit_cast(float, w & 0xffff0000u); }

#define XB_TMO      128
#define XB_XCNT(j)  (256  + 64 * (j))
#define XB_XSUB(j)  (1280 + 64 * (j))
#define XB_XGEN(j)  (2304 + 64 * (j))
#define XB_TOP      3328
#define XB_TOPGEN   3392
#define XCD_BAR_WORDS 3456
#define XB_SPIN_CAP (1u << 18)
__device__ __forceinline__ unsigned xb_ld(unsigned* p)              { return __hip_atomic_load(p, __ATOMIC_RELAXED, __HIP_MEMORY_SCOPE_AGENT); }
__device__ __forceinline__ unsigned xb_add(unsigned* p, unsigned v) { return __hip_atomic_fetch_add(p, v, __ATOMIC_RELAXED, __HIP_MEMORY_SCOPE_AGENT); }
__device__ __forceinline__ unsigned xb_xcc_id() { return (unsigned)__builtin_amdgcn_s_getreg((3 << 11) | 20) & 0xFu; }
#define XB_SPIN(cond, bar) do { unsigned _sp = 0; while (cond) { __builtin_amdgcn_s_sleep(1); \
    if ((++_sp & 255u) == 0u) { if (xb_ld(&(bar)[XB_TMO])) break; if (_sp > XB_SPIN_CAP) { atomicAdd(&(bar)[XB_TMO], 1u); break; } } } } while (0)
struct XcdBarrier { unsigned* bar; unsigned x; volatile LAS unsigned* st; };
__device__ __forceinline__ XcdBarrier xcd_barrier_post(unsigned* bar, volatile LAS unsigned* st) {
    XcdBarrier b; b.bar = bar; b.x = xb_xcc_id(); b.st = st;
    if (threadIdx.x == 0) (void)xb_add(&bar[XB_XCNT(b.x)], 1u);
    return b;
}
__device__ __forceinline__ void xcd_barrier_complete(unsigned* bar, unsigned x, unsigned& nloc, unsigned& nx) {
    const unsigned G = gridDim.x * gridDim.y * gridDim.z;
    unsigned sum, cnt, mine, sp = 0u;
    for (;;) {
        sum = 0u; cnt = 0u; mine = 0u;
#pragma unroll
        for (unsigned j = 0; j < 16; ++j) { const unsigned c = xb_ld(&bar[XB_XCNT(j)]); sum += c; cnt += (c > 0u) ? 1u : 0u; mine = (j == x) ? c : mine; }
        if (sum == G) break;
        __builtin_amdgcn_s_sleep(1);
        if ((++sp & 255u) == 0u) { if (xb_ld(&bar[XB_TMO])) break; if (sp > XB_SPIN_CAP) { atomicAdd(&bar[XB_TMO], 1u); break; } }
    }
    nloc = mine > 0u ? mine : 1u; nx = cnt > 0u ? cnt : 1u;
}
__device__ __forceinline__ void xcd_barrier(const XcdBarrier& b) {
    asm volatile("s_waitcnt vmcnt(0)" ::: "memory");
    __syncthreads();
    if (threadIdx.x == 0) {
        unsigned* bar = b.bar;
        __builtin_amdgcn_s_waitcnt(0);
        unsigned nloc = b.st[0], nx = b.st[1];
        if (nloc == 0u) { xcd_barrier_complete(bar, b.x, nloc, nx); b.st[0] = nloc; b.st[1] = nx; }
        const unsigned old = xb_add(&bar[XB_XSUB(b.x)], 1u);
        const unsigned gen = old / nloc;
        if (old + 1u == (gen + 1u) * nloc) {
            __builtin_amdgcn_fence(__ATOMIC_RELEASE, "agent");
            asm volatile("s_waitcnt vmcnt(0)" ::: "memory");
            const unsigned og = xb_add(&bar[XB_TOP], 1u);
            const unsigned tg = og / nx;
            if (og + 1u == (tg + 1u) * nx) xb_add(&bar[XB_TOPGEN], 1u);
            else XB_SPIN(xb_ld(&bar[XB_TOPGEN]) == tg, bar);
            __builtin_amdgcn_fence(__ATOMIC_ACQUIRE, "agent");
            xb_add(&bar[XB_XGEN(b.x)], 1u);
            asm volatile("s_waitcnt vmcnt(0)" ::: "memory");
        } else {
            XB_SPIN(xb_ld(&bar[XB_XGEN(b.x)]) == gen, bar);
            __builtin_amdgcn_fence(__ATOMIC_ACQUIRE, "agent");
            asm volatile("s_waitcnt vmcnt(0)" ::: "memory");
        }
    }
    __syncthreads();
}

struct Args {
    const float* x_prompt; const float* x_sample; const float* state_gla; const float* state_ret; const float* norm_w; const float* w_in;
    const float* gla_w2; const float* gla_b; const float* gla_norm_w; const float* ret_norm_w; const float* ret_norm_b; const float* w_out; const float* final_norm_w;
    float* out; unsigned char* ws; int ph_lo, ph_hi;
};
struct Frame {
    LAS unsigned char* lds; int tid, lane, wave, vcu, G;
};

__device__ __forceinline__ float wave_sum(float v) {
#pragma unroll
    for (int o = 1; o < 64; o <<= 1) v += __shfl_xor(v, o);
    return v;
}

__device__ __forceinline__ void p0_transpose_item(const float* W, int K, int N, bf16* WT, LAS float* scr, int item, int nblk, int lane, int s0a, int s0b, int s1a, int s1b) {
    const int kb = item / nblk, nb = item % nblk, k0 = 64 * kb, n0 = 32 * nb;
    const int ncol = n0 + (lane & 31);
    const float sc = ((ncol >= s0a && ncol < s0b) || (ncol >= s1a && ncol < s1b)) ? 0.125f : 1.0f;
#pragma unroll 8
    for (int i = 0; i < 32; ++i) { const int kk = 2 * i + (lane >> 5); scr[kk * 33 + (lane & 31)] = (ncol < N) ? W[(size_t)(k0 + kk) * N + ncol] * sc : 0.f; }
    LDS_WAIT(); asm volatile("" ::: "memory");
    const int c = lane & 7;
#pragma unroll
    for (int j = 0; j < 4; ++j) { const int n = (lane >> 3) + 8 * j; const LAS float* s = scr + (8 * c) * 33 + n;
        v4u o; o.x = pk2(s[0 * 33], s[1 * 33]); o.y = pk2(s[2 * 33], s[3 * 33]); o.z = pk2(s[4 * 33], s[5 * 33]); o.w = pk2(s[6 * 33], s[7 * 33]);
        *(GAS v4u*)(WT + (size_t)(n0 + n) * K + k0 + 8 * c) = o; }
    LDS_WAIT(); asm volatile("" ::: "memory");
}
__device__ __forceinline__ void rms_row_to_bf16(int lane, const float* xrow, const float* w, bf16* orow) {
    const GAS f32x4* xr = (const GAS f32x4*)xrow + lane; const GAS f32x4* wr = (const GAS f32x4*)w + lane;
    f32x4 v[4]; float s2 = 0.f;
#pragma unroll
    for (int j = 0; j < 4; ++j) { v[j] = xr[64 * j]; s2 += (v[j].x * v[j].x + v[j].y * v[j].y) + (v[j].z * v[j].z + v[j].w * v[j].w); }
    const float rs = 1.f / sqrtf(wave_sum(s2) * (1.f / D) + EPS);
    GAS unsigned long long* o8 = (GAS unsigned long long*)orow + lane;
#pragma unroll
    for (int j = 0; j < 4; ++j) { const f32x4 ww = wr[64 * j]; o8[64 * j] = (unsigned long long)pk2(v[j].x * rs * ww.x, v[j].y * rs * ww.y) | ((unsigned long long)pk2(v[j].z * rs * ww.z, v[j].w * rs * ww.w) << 32); }
}
__device__ __forceinline__ void rms_row_to_f32(int lane, const float* xrow, const float* w, float* orow) {
    const GAS f32x4* xr = (const GAS f32x4*)xrow + lane; const GAS f32x4* wr = (const GAS f32x4*)w + lane;
    f32x4 v[4]; float s2 = 0.f;
#pragma unroll
    for (int j = 0; j < 4; ++j) { v[j] = xr[64 * j]; s2 += (v[j].x * v[j].x + v[j].y * v[j].y) + (v[j].z * v[j].z + v[j].w * v[j].w); }
    const float rs = 1.f / sqrtf(wave_sum(s2) * (1.f / D) + EPS);
    GAS f32x4* o = (GAS f32x4*)orow + lane;
#pragma unroll
    for (int j = 0; j < 4; ++j) { const f32x4 ww = wr[64 * j]; o[64 * j] = (f32x4){v[j].x * rs * ww.x, v[j].y * rs * ww.y, v[j].z * rs * ww.z, v[j].w * rs * ww.w}; }
}
__device__ __forceinline__ void rope_sincos(int pos, int i, float& c, float& s) {
    double inv = 1.0; const double r = 0.74989420933245582730;
    for (int k = 0; k < i; ++k) inv *= r;
    const double ang = (double)pos * inv;
    const double kq = __builtin_rint(ang * 0.63661977236758134308);
    double y = __builtin_fma(-kq, 1.57079632679489655800e+00, ang); y = __builtin_fma(-kq, 6.12323399573676603587e-17, y);
    const double y2 = y * y;
    double sp = -2.5052108385441718775e-08; sp = sp * y2 + 2.7557319223985890653e-06; sp = sp * y2 - 1.9841269841269841253e-04; sp = sp * y2 + 8.3333333333333332177e-03; sp = sp * y2 - 1.6666666666666665741e-01; sp = y + y * y2 * sp;
    double cp = 2.0876756987868098979e-09; cp = cp * y2 - 2.7557319223985888276e-07; cp = cp * y2 + 2.4801587301587301566e-05; cp = cp * y2 - 1.3888888888888889419e-03; cp = cp * y2 + 4.1666666666666664354e-02; cp = cp * y2 - 0.5; cp = 1.0 + y2 * cp;
    const int q = ((int)(long long)kq) & 3;
    const double sv = (q == 0) ? sp : (q == 1) ? cp : (q == 2) ? -sp : -cp;
    const double cv = (q == 0) ? cp : (q == 1) ? -sp : (q == 2) ? -cp : sp;
    c = (float)cv; s = (float)sv;
}
__device__ __forceinline__ void p0_prologue(const Frame& F, const Args& a) {
    LAS float* scr = (LAS float*)(F.lds + RING_OFF + F.wave * 16384);
    const int gw = F.vcu * NWAVES + F.wave, NGW = F.G * NWAVES;
    constexpr int NB_IN = NINP / 32, I_IN = (D / 64) * NB_IN, NB_O = D / 32, I_O = (D / 64) * NB_O;
    constexpr int NITEMS = 2 * I_IN + 2 * I_O;
    bf16* win = (bf16*)(a.ws + WS_WIN); bf16* wout = (bf16*)(a.ws + WS_WOUT);
    for (int it = gw; it < NITEMS; it += NGW) {
        int r = it;
        if (r < 2 * I_IN) { const int l = r / I_IN; r -= l * I_IN; p0_transpose_item(a.w_in + (size_t)l * D * NIN, D, NIN, win + (size_t)l * NINP * D, scr, r, NB_IN, F.lane, C_GQ, C_GQ + 256, C_RK, C_RK + 256); continue; }
        r -= 2 * I_IN;
        { const int l = r / I_O; r -= l * I_O; p0_transpose_item(a.w_out + (size_t)l * D * D, D, D, wout + (size_t)l * D * D, scr, r, NB_O, F.lane, 0, 0, 0, 0); }
    }
    float* rope = (float*)(a.ws + WS_ROPE);
    for (int e = (F.vcu * NWAVES * 64 + F.tid); e < NPOS * 32; e += F.G * NWAVES * 64) {
        const int p = e >> 5, i = e & 31; float c, s; rope_sincos(p == SEQ ? 16384 : p, i, c, s);
        rope[p * 64 + i] = c; rope[p * 64 + 32 + i] = s;
    }
    bf16* H = (bf16*)(a.ws + WS_H);
    for (int m = gw; m < MPAD; m += NGW) {
        if (m < MP) rms_row_to_bf16(F.lane, a.x_prompt + (size_t)m * D, a.norm_w, H + (size_t)m * D);
        else if (m < MROWS) rms_row_to_bf16(F.lane, a.x_sample + (size_t)(m - MP) * D, a.norm_w, H + (size_t)m * D);
        else { GAS unsigned long long* o8 = (GAS unsigned long long*)(H + (size_t)m * D) + F.lane;
#pragma unroll
            for (int j = 0; j < 4; ++j) o8[64 * j] = 0ull; }
    }
}

__device__ __forceinline__ void p4_norm(const Frame& F, const Args& a, int l) {
    const int gw = F.vcu * NWAVES + F.wave, NGW = F.G * NWAVES;
    bf16* H = (bf16*)(a.ws + WS_H); float* XS = (float*)(a.ws + WS_XS);
    for (int m = gw; m < MROWS; m += NGW) {
        const float* src = (m < MP) ? a.out + O_Y + (size_t)m * D : XS + (size_t)(m - MP) * D;
        if (l == 0) rms_row_to_bf16(F.lane, src, a.norm_w + D, H + (size_t)m * D);
        else rms_row_to_f32(F.lane, src, a.final_norm_w, (m < MP) ? a.out + O_Y + (size_t)m * D : a.out + O_YS + (size_t)(m - MP) * D);
    }
}

__device__ __forceinline__ float log_sigmoid(float x) { return fminf(x, 0.f) - log1pf(expf(-fabsf(x))); }
__device__ __forceinline__ float silu(float x) { return x / (1.f + expf(-x)); }
__device__ __forceinline__ void p2_item(const Frame& F, const Args& a, int l, int row0, int ntok, int pos0row, int hd, const float* s_in, float* s_out) {
    LAS float* qs = (LAS float*)(F.lds); LAS float* ks = qs + 2048; LAS float* dc = ks + 2048; LAS float* ob = dc + 2048; LAS float* st = ob + 4096;
    const bf16* Z = (const bf16*)(a.ws + WS_Z); bf16* MIX = (bf16*)(a.ws + WS_MIX); const float* rope = (const float*)(a.ws + WS_ROPE);
    const bool gla = hd < 4; const int hh = hd & 3;
    const int cq = gla ? C_GQ + 64 * hh : C_RQ + 64 * hh, ck = gla ? C_GK + 64 * hh : C_RK + 64 * hh, cv = gla ? C_GV + 128 * hh : C_RV + 128 * hh, cg = gla ? C_GG + 128 * hh : C_RG + 128 * hh;
    const float lgam = logf(1.0f - exp2f(-5.0f - (float)hh)), gam = 1.0f - exp2f(-5.0f - (float)hh);
    const int tid = F.tid;
    float S[64];
    if (tid < 128) {
#pragma unroll
        for (int f = 0; f < 64; ++f) S[f] = s_in ? s_in[f * 128 + tid] : 0.f;
    }
    (void)lgam;
    for (int t0 = 0; t0 < ntok; t0 += 32) {
        const int nb = (ntok - t0) < 32 ? (ntok - t0) : 32;
        { const int t = tid >> 4, f0 = (tid & 15) * 4;
          if (t < nb) {
            const bf16* zr = Z + (size_t)(row0 + t0 + t) * NINP;
            if (gla) {
                float pre[4];
#pragma unroll
                for (int j = 0; j < 4; ++j) pre[j] = a.gla_b[l * 256 + hh * 64 + f0 + j];
                for (int r = 0; r < 16; ++r) { const float g = bf2f(zr[C_LR + r]);
#pragma unroll
                    for (int j = 0; j < 4; ++j) pre[j] += g * a.gla_w2[(size_t)l * 16 * 256 + r * 256 + hh * 64 + f0 + j]; }
#pragma unroll
                for (int j = 0; j < 4; ++j) { dc[t * 64 + f0 + j] = expf(log_sigmoid(pre[j]) * (1.f / 16.f)); qs[t * 64 + f0 + j] = bf2f(zr[cq + f0 + j]); ks[t * 64 + f0 + j] = bf2f(zr[ck + f0 + j]); }
            } else {
                const int p = pos0row + ((pos0row == SEQ) ? 0 : (t0 + t));
#pragma unroll
                for (int j = 0; j < 4; ++j) { const int f = f0 + j, i = f & 31; const float c = rope[p * 64 + i], s = rope[p * 64 + 32 + i];
                    const float q1 = bf2f(zr[cq + i]), q2 = bf2f(zr[cq + 32 + i]), k1 = bf2f(zr[ck + i]), k2 = bf2f(zr[ck + 32 + i]);
                    qs[t * 64 + f] = (f < 32) ? q1 * c - q2 * s : q1 * s + q2 * c; ks[t * 64 + f] = (f < 32) ? k1 * c - k2 * s : k1 * s + k2 * c; dc[t * 64 + f] = gam; }
            }
          } }
        __syncthreads();
        if (tid < 128) {
            for (int t = 0; t < nb; ++t) {
                const float v = bf2f(Z[(size_t)(row0 + t0 + t) * NINP + cv + tid]);
                float o = 0.f;
#pragma unroll
                for (int f = 0; f < 64; ++f) { S[f] = dc[t * 64 + f] * S[f] + ks[t * 64 + f] * v; o += qs[t * 64 + f] * S[f]; }
                ob[t * 128 + tid] = o;
            }
        }
        __syncthreads();
        if (tid < nb) { float s = 0.f, s2 = 0.f;
            for (int d = 0; d < 128; ++d) { const float o = ob[tid * 128 + ((d + tid) & 127)]; s += o; s2 += o * o; }
            if (gla) { st[tid * 2] = 0.f; st[tid * 2 + 1] = 1.f / sqrtf(s2 * (1.f / 128.f) + EPS); }
            else { const float mu = s * (1.f / 128.f); float var = 0.f;
                for (int d = 0; d < 128; ++d) { const float o = ob[tid * 128 + ((d + tid) & 127)] - mu; var += o * o; }
                st[tid * 2] = mu; st[tid * 2 + 1] = 1.f / sqrtf(var * (1.f / 128.f) + GN_EPS); } }
        __syncthreads();
        for (int e = tid; e < nb * 128; e += 512) { const int t = e >> 7, d = e & 127;
            const float o = (ob[e] - st[t * 2]) * st[t * 2 + 1];
            const float g = bf2f(Z[(size_t)(row0 + t0 + t) * NINP + cg + d]);
            float y;
            if (gla) y = o * a.gla_norm_w[l * 128 + d] * silu(g);
            else y = (o * a.ret_norm_w[l * 512 + hh * 128 + d] + a.ret_norm_b[l * 512 + hh * 128 + d]) * silu(g);
            MIX[(size_t)(row0 + t0 + t) * D + hd * 128 + d] = (bf16)f2bf(y); }
        __syncthreads();
    }
    if (tid < 128) {
#pragma unroll
        for (int f = 0; f < 64; ++f) s_out[f * 128 + tid] = S[f];
    }
    __syncthreads();
}
__device__ __forceinline__ void p2_simple(const Frame& F, const Args& a, int l) {
    const int NIT = BATCH * 8 + DEC * 8;
    for (int it = F.vcu; it < NIT; it += F.G) {
        int row0, ntok, posrow, hd; const float* si; float* so;
        if (it < BATCH * 8) { const int b = it >> 3; hd = it & 7; const bool gla = hd < 4; const int hh = hd & 3;
            so = a.out + (gla ? O_GP : O_RP) + ((size_t)(l * BATCH + b) * 4 + hh) * 8192; si = nullptr; row0 = b * SEQ; ntok = SEQ; posrow = 0;
        } else { const int j = it - BATCH * 8, n = j >> 3; hd = j & 7; const bool gla = hd < 4; const int hh = hd & 3;
            si = (gla ? a.state_gla : a.state_ret) + ((size_t)(l * DEC + n) * 4 + hh) * 8192;
            so = a.out + (gla ? O_GS : O_RS) + ((size_t)(l * DEC + n) * 4 + hh) * 8192; row0 = MP + n; ntok = 1; posrow = SEQ;
        }
        p2_item(F, a, l, row0, ntok, posrow, hd, si, so);
    }
}

constexpr int N_PHASES = 9;
__global__ void __launch_bounds__(NWAVES * 64, 2) hymba_fwd(Args args) {
    extern __shared__ __attribute__((aligned(16))) unsigned char lds[];
    Frame F;
    F.lds = (LAS unsigned char*)lds;
    F.tid = threadIdx.x; F.lane = F.tid & 63; F.wave = __builtin_amdgcn_readfirstlane(F.tid >> 6);
    F.G = gridDim.x; { const int bx = blockIdx.x; F.vcu = (F.G % 8 == 0) ? (bx % 8) * (F.G / 8) + bx / 8 : bx; }
    volatile LAS unsigned* MISC = (volatile LAS unsigned*)(F.lds + MISC_OFF);
    if (F.tid < 64) MISC[F.tid] = 0u;
    __syncthreads();
    unsigned* ctl = (unsigned*)(args.ws + WS_CTL);
    XcdBarrier bar; bar.bar = ctl + CW_BAR; bar.x = 0; bar.st = nullptr;
    const int lo = args.ph_lo, hi = args.ph_hi;
    const bool multi = (hi - lo) > 1;
    if (multi) bar = xcd_barrier_post(ctl + CW_BAR, MISC + 8);
#define IN(k) (lo <= (k) && (k) < hi)
#define SEAM(k) do { if (IN(k) && IN((k) + 1)) xcd_barrier(bar); } while (0)

    if (IN(0)) { p0_prologue(F, args); SEAM(0); }
#pragma unroll
    for (int l = 0; l < DEPTH; ++l) {
        const int pb = 1 + 4 * l;
        if (IN(pb)) {
            pg8::Gemm g{(const bf16*)(args.ws + WS_H), (const bf16*)(args.ws + WS_WIN) + (size_t)l * NINP * D, MPAD, NINP, D};
            pg8::StaticOrder S; S.init(MPAD, NINP, F.G, (int)blockIdx.x);
            pg8::EpiBf16 E{(bf16*)(args.ws + WS_Z), NINP};
            pg8::gemm_phase<pg8::EpiBf16, pg8::StaticOrder>(F.lds + RING_OFF, g, S, E);
            SEAM(pb);
        }
        if (IN(pb + 1)) { p2_simple(F, args, l); SEAM(pb + 1); }
        if (IN(pb + 2)) {
            pg8::Gemm g{(const bf16*)(args.ws + WS_MIX), (const bf16*)(args.ws + WS_WOUT) + (size_t)l * D * D, MPAD, D, D};
            pg8::StaticOrder S; S.init(MPAD, D, F.G, (int)blockIdx.x);
            pg8::EpiResid E{l == 0 ? args.x_prompt : args.out + O_Y, args.out + O_Y, l == 0 ? args.x_sample : (const float*)(args.ws + WS_XS), (float*)(args.ws + WS_XS), D, MP};
            pg8::gemm_phase<pg8::EpiResid, pg8::StaticOrder>(F.lds + RING_OFF, g, S, E);
            SEAM(pb + 2);
        }
        if (IN(pb + 3)) { p4_norm(F, args, l); SEAM(pb + 3); }
    }
#undef IN
#undef SEAM
}

extern "C" void kernel_launch(void* const* d_in, const int* in_sizes, int n_in, void* d_out, int out_size, void* d_ws, size_t ws_size, hipStream_t stream) {
    static int grid = 0;
    if (grid == 0) {
        int dev = 0, cus = 0, per_cu = 0;
        if (n_in != 13 || ws_size < WS_END) { fprintf(stderr, "kernel_launch: unexpected n_in %d / ws %zu\n", n_in, ws_size); grid = -1; return; }
        if (hipGetDevice(&dev) != hipSuccess || hipDeviceGetAttribute(&cus, hipDeviceAttributeMultiprocessorCount, dev) != hipSuccess) { grid = -1; return; }
        if (hipFuncSetAttribute((const void*)hymba_fwd, hipFuncAttributeMaxDynamicSharedMemorySize, LDS_BYTES) != hipSuccess) { fprintf(stderr, "kernel_launch: hipFuncSetAttribute failed\n"); grid = -1; return; }
        if (hipOccupancyMaxActiveBlocksPerMultiprocessor(&per_cu, (const void*)hymba_fwd, NWAVES * 64, LDS_BYTES) != hipSuccess || per_cu < 1) { fprintf(stderr, "kernel_launch: occupancy query says %d\n", per_cu); per_cu = 1; }
        (void)hipGetLastError();
        grid = cus * 1;
    }
    if (grid < 0) return;
    (void)hipMemsetAsync((char*)d_ws + WS_CTL, 0, CTL_ZERO_BYTES, stream);
    Args a{};
    a.x_prompt = (const float*)d_in[0]; a.x_sample = (const float*)d_in[1]; a.state_gla = (const float*)d_in[2]; a.state_ret = (const float*)d_in[3];
    a.norm_w = (const float*)d_in[4]; a.w_in = (const float*)d_in[5]; a.gla_w2 = (const float*)d_in[6]; a.gla_b = (const float*)d_in[7];
    a.gla_norm_w = (const float*)d_in[8]; a.ret_norm_w = (const float*)d_in[9]; a.ret_norm_b = (const float*)d_in[10]; a.w_out = (const float*)d_in[11];
    a.final_norm_w = (const float*)d_in[12];
    a.out = (float*)d_out; a.ws = (unsigned char*)d_ws;
#if MK_ONE_LAUNCH
    a.ph_lo = 0; a.ph_hi = N_PHASES;
    hipLaunchKernelGGL(hymba_fwd, dim3(grid), dim3(NWAVES * 64), LDS_BYTES, stream, a);
#else
    for (int p = 0; p < N_PHASES; ++p) { a.ph_lo = p; a.ph_hi = p + 1; hipLaunchKernelGGL(hymba_fwd, dim3(grid), dim3(NWAVES * 64), LDS_BYTES, stream, a); }
#endif
}
```

```cpp
#include <hip/hip_runtime.h>
#include <cstdio>
#include <cstdint>

#ifndef P2_FAST
#define P2_FAST 1
#endif
#ifndef MK_ONE_LAUNCH
#define MK_ONE_LAUNCH 1
#endif

namespace pg8 {
#define PG8_LAS __attribute__((address_space(3)))
typedef unsigned short bf16_t;
typedef short bf16x8 __attribute__((ext_vector_type(8)));
typedef float f32x4 __attribute__((ext_vector_type(4)));
typedef unsigned u32x4 __attribute__((ext_vector_type(4)));
constexpr int BM = 256, BK = 64, HALF = 128, HTB = HALF * BK * 2, STAGE_BYTES = 8 * HTB, NXCD = 8, WGM = 8;

__host__ __device__ __forceinline__ int lds_byte(int r, int c) { const int st = (r >> 4) * 2 + (c >> 5), rr = r & 15, cc = c & 31, ob = rr * 64 + cc * 2; return st * 1024 + (ob ^ (((ob >> 9) & 1) << 5)); }
__host__ __device__ __forceinline__ void stage_rc(int b, int& R, int& C) { const int st = b / 1024, sb = b % 1024, swz = sb ^ (((sb >> 9) & 1) << 5); R = (st >> 1) * 16 + swz / 64; C = (st & 1) * 32 + (swz % 64) / 2; }
__host__ __device__ __forceinline__ int perm32(int rho) { const int n = rho >> 4, i = rho & 15; return 8 * (i >> 2) + 4 * n + (i & 3); }

struct Unit { int pm, pn; };
struct Gemm { const bf16_t* A; const bf16_t* Bt; int M, N, K; };

struct StaticOrder {
    int nM, nN, nwg, G, c;
    __host__ __device__ void init(int M, int N, int G_, int c_) { nM = M / BM; nN = N / BM; nwg = nM * nN; G = G_; c = c_; }
    __host__ __device__ bool next(int i, Unit& u) const {
        const long L = (long)i * G + c; if (L >= nwg) return false;
        int wgid = (int)L; { const int q = nwg / NXCD, r = nwg % NXCD, xcd = wgid % NXCD, off = wgid / NXCD; wgid = (xcd < r ? xcd * (q + 1) : r * (q + 1) + (xcd - r) * q) + off; }
        const int nig = WGM * nN, gid = wgid / nig, fm = gid * WGM, gsz = (nM - fm) < WGM ? (nM - fm) : WGM;
        u.pm = fm + ((wgid % nig) % gsz); u.pn = (wgid % nig) / gsz; return true;
    }
    __device__ __forceinline__ void a_ready(const Unit&) const {}
    __device__ __forceinline__ void done(const Unit&) const {}
};

__device__ __forceinline__ unsigned cvt_pk_bf16(float lo, float hi) { unsigned r; asm volatile("v_cvt_pk_bf16_f32 %0, %1, %2" : "=v"(r) : "v"(lo), "v"(hi)); return r; }

struct EpiBf16 {
    static constexpr bool PERM = true, AFTER_DRAIN = false;
    bf16_t* O; int ldc;
    __device__ __forceinline__ void operator()(const f32x4 (&acc)[2][2][4][2], const Unit& u, int wr, int wc, int fr, int fq) const {
        const int row0 = u.pm * BM + wr * 64 + fr; const int col0 = u.pn * BM + wc * 32 + 8 * fq;
#pragma unroll
        for (int ai = 0; ai < 2; ++ai)
#pragma unroll
            for (int m = 0; m < 4; ++m) { bf16_t* rowp = O + (size_t)(row0 + ai * HALF + m * 16) * ldc + col0;
#pragma unroll
                for (int bj = 0; bj < 2; ++bj) { const f32x4 v0 = acc[ai][bj][m][0], v1 = acc[ai][bj][m][1];
                    u32x4 w; w.x = cvt_pk_bf16(v0[0], v0[1]); w.y = cvt_pk_bf16(v0[2], v0[3]); w.z = cvt_pk_bf16(v1[0], v1[1]); w.w = cvt_pk_bf16(v1[2], v1[3]);
                    *(u32x4*)(rowp + bj * HALF) = w; } }
    }
};
struct EpiResid {
    static constexpr bool PERM = false, AFTER_DRAIN = false;
    const float* base0; float* out0; const float* base1; float* out1; int ldc; int MP;
    __device__ __forceinline__ void operator()(const f32x4 (&acc)[2][2][4][2], const Unit& u, int wr, int wc, int fr, int fq) const {
        const int row0 = u.pm * BM + wr * 64 + fr, col0 = u.pn * BM + wc * 32 + 4 * fq;
        const bool tail = (u.pm * BM >= MP);
#pragma unroll
        for (int ai = 0; ai < 2; ++ai) {
            if (tail && ai == 1) continue;
#pragma unroll
            for (int m = 0; m < 4; ++m) {
                const int row = row0 + ai * HALF + m * 16;
                const float* bp = tail ? base1 + (size_t)(row - MP) * ldc + col0 : base0 + (size_t)row * ldc + col0;
                float* op = tail ? out1 + (size_t)(row - MP) * ldc + col0 : out0 + (size_t)row * ldc + col0;
#pragma unroll
                for (int bj = 0; bj < 2; ++bj)
#pragma unroll
                    for (int n = 0; n < 2; ++n) { const f32x4 b = *(const f32x4*)(bp + bj * HALF + n * 16); *(f32x4*)(op + bj * HALF + n * 16) = acc[ai][bj][m][n] + b; }
            }
        }
    }
};

template <class Epi, class Sched>
__device__ __forceinline__ void gemm_phase(PG8_LAS unsigned char* lds, const Gemm g, const Sched& S, const Epi& E) {
    const int tid = threadIdx.x, wid = __builtin_amdgcn_readfirstlane(tid >> 6), lane = tid & 63, wr = wid >> 2, wc = wid & 3, fr = lane & 15, fq = lane >> 4;
    const int K = g.K, nt = K / BK;
    unsigned voffA[2], voffB[2];
#pragma unroll
    for (int i = 0; i < 2; ++i) { int R, C; stage_rc(tid * 16 + i * 8192, R, C); const int Rb = Epi::PERM ? ((R & ~31) + perm32(R & 31)) : R;
        voffA[i] = (unsigned)(R * K + C) * 2u; voffB[i] = (unsigned)(Rb * K + C) * 2u; }
    const size_t kstep = (size_t)(BK * 2);
    const size_t hstep = (size_t)HALF * K * 2;
    const size_t tstep = 2 * hstep;
    const unsigned ldsw = (unsigned)wid * 1024u;
    const int aoff = lds_byte(wr * 64 + fr, fq * 8), boff = lds_byte(wc * 32 + fr, fq * 8);
#define PG8_SA(b, h) (((b) * 2 + (h)) * HTB)
#define PG8_SB(b, h) ((4 + (b) * 2 + (h)) * HTB)
#define PG8_STAGE(bufoff, gbase, voff) do { _Pragma("unroll") for (int _i = 0; _i < 2; ++_i) \
        __builtin_amdgcn_global_load_lds((const unsigned*)((const char*)(gbase) + (voff)[_i]), (PG8_LAS unsigned*)(lds + (bufoff) + ldsw + _i * 8192), 16, 0, 0); } while (0)
#define PG8_LDA(dst, b, h) do { _Pragma("unroll") for (int m = 0; m < 4; ++m) _Pragma("unroll") for (int k = 0; k < 2; ++k) dst[m][k] = *(const PG8_LAS bf16x8*)(lds + PG8_SA(b, h) + aoff + m * 2048 + k * 1024); } while (0)
#define PG8_LDB(dst, b, h) do { _Pragma("unroll") for (int n = 0; n < 2; ++n) _Pragma("unroll") for (int k = 0; k < 2; ++k) dst[n][k] = *(const PG8_LAS bf16x8*)(lds + PG8_SB(b, h) + boff + n * 2048 + k * 1024); } while (0)
#define PG8_MMA(ai, bj, At, Bt) do { __builtin_amdgcn_s_setprio(1); _Pragma("unroll") for (int m = 0; m < 4; ++m) _Pragma("unroll") for (int n = 0; n < 2; ++n) _Pragma("unroll") for (int k = 0; k < 2; ++k) \
        acc[ai][bj][m][n] = __builtin_amdgcn_mfma_f32_16x16x32_bf16(Bt[n][k], At[m][k], acc[ai][bj][m][n], 0, 0, 0); __builtin_amdgcn_s_setprio(0); } while (0)
#define PG8_WAIT_V(n) asm volatile("s_waitcnt vmcnt(" #n ")" ::: "memory")
#define PG8_WAIT_L(n) asm volatile("s_waitcnt lgkmcnt(" #n ")" ::: "memory")
#define PG8_BAR __builtin_amdgcn_s_barrier()
#define PG8_SCHED __builtin_amdgcn_sched_barrier(0)
    Unit cur, nxt; int ui = 0;
    if (!S.next(0, cur)) return;
    f32x4 acc[2][2][4][2];
#pragma unroll
    for (int a = 0; a < 2; ++a)
#pragma unroll
        for (int b = 0; b < 2; ++b)
#pragma unroll
            for (int m = 0; m < 4; ++m)
#pragma unroll
                for (int n = 0; n < 2; ++n) acc[a][b][m][n] = (f32x4){0.f, 0.f, 0.f, 0.f};
    bf16x8 At[4][2], B0[2][2], B1[2][2];
    const char* cA = (const char*)g.A + (size_t)cur.pm * tstep; const char* cB = (const char*)g.Bt + (size_t)cur.pn * tstep;
    S.a_ready(cur);
    PG8_STAGE(PG8_SB(0, 0), cB, voffB); PG8_STAGE(PG8_SB(0, 1), cB + hstep, voffB); PG8_STAGE(PG8_SA(0, 0), cA, voffA); PG8_STAGE(PG8_SA(0, 1), cA + hstep, voffA);
    if (wr == 1) PG8_BAR;
    PG8_WAIT_V(2); PG8_BAR;
    PG8_STAGE(PG8_SB(1, 0), cB + kstep, voffB); PG8_STAGE(PG8_SA(1, 0), cA + kstep, voffA); PG8_STAGE(PG8_SB(1, 1), cB + hstep + kstep, voffB);
    PG8_WAIT_V(6); PG8_BAR;
    for (;;) {
        const bool has_next = S.next(ui + 1, nxt);
        const char* nA = has_next ? (const char*)g.A + (size_t)nxt.pm * tstep : cA; const char* nB = has_next ? (const char*)g.Bt + (size_t)nxt.pn * tstep : cB;
        for (int t = 0; t < nt; t += 2) {
            const bool last = (t == nt - 2);
            const char* a1 = cA + (size_t)(t + 1) * kstep;
            const char* a2 = last ? nA : cA + (size_t)(t + 2) * kstep; const char* b2 = last ? nB : cB + (size_t)(t + 2) * kstep;
            const char* a3 = a2 + kstep; const char* b3 = b2 + kstep;
            if (last && has_next) S.a_ready(nxt);
            PG8_LDB(B0, 0, 0); PG8_LDB(B1, 0, 1); PG8_SCHED; PG8_LDA(At, 0, 0); PG8_STAGE(PG8_SA(1, 1), a1 + hstep, voffA);
            PG8_WAIT_V(8); PG8_WAIT_L(0); PG8_BAR; PG8_MMA(0, 0, At, B0); PG8_MMA(0, 1, At, B1); PG8_BAR; PG8_SCHED;
            PG8_LDA(At, 0, 1); PG8_STAGE(PG8_SB(0, 0), b2, voffB); PG8_STAGE(PG8_SB(0, 1), b2 + hstep, voffB); PG8_STAGE(PG8_SA(0, 0), a2, voffA);
            PG8_WAIT_V(8); PG8_WAIT_L(0); PG8_BAR; PG8_MMA(1, 0, At, B0); PG8_MMA(1, 1, At, B1); PG8_BAR; PG8_SCHED;
            PG8_LDB(B0, 1, 0); PG8_LDB(B1, 1, 1); PG8_SCHED; PG8_LDA(At, 1, 0); PG8_STAGE(PG8_SA(0, 1), a2 + hstep, voffA);
            PG8_WAIT_V(8); PG8_WAIT_L(0); PG8_BAR; PG8_MMA(0, 0, At, B0); PG8_MMA(0, 1, At, B1); PG8_BAR; PG8_SCHED;
            PG8_LDA(At, 1, 1); PG8_STAGE(PG8_SB(1, 0), b3, voffB); PG8_STAGE(PG8_SB(1, 1), b3 + hstep, voffB); PG8_STAGE(PG8_SA(1, 0), a3, voffA);
            PG8_WAIT_V(8); PG8_WAIT_L(0); PG8_BAR; PG8_MMA(1, 0, At, B0); PG8_MMA(1, 1, At, B1); PG8_BAR; PG8_SCHED;
        }
        if (wr == 0) PG8_BAR;
        if constexpr (!Epi::AFTER_DRAIN) { E(acc, cur, wr, wc, fr, fq); S.done(cur); }
        if (!has_next) break;
#pragma unroll
        for (int a = 0; a < 2; ++a)
#pragma unroll
            for (int b = 0; b < 2; ++b)
#pragma unroll
                for (int m = 0; m < 4; ++m)
#pragma unroll
                    for (int n = 0; n < 2; ++n) acc[a][b][m][n] = (f32x4){0.f, 0.f, 0.f, 0.f};
        cur = nxt; cA = nA; cB = nB; ++ui;
        if (wr == 1) PG8_BAR;
    }
    PG8_WAIT_V(0);
    PG8_BAR;
#undef PG8_SA
#undef PG8_SB
#undef PG8_STAGE
#undef PG8_LDA
#undef PG8_LDB
#undef PG8_MMA
#undef PG8_WAIT_V
#undef PG8_WAIT_L
#undef PG8_BAR
#undef PG8_SCHED
}
}

constexpr int NWAVES = 8;
constexpr int D = 1024, BATCH = 8, SEQ = 2048, DEPTH = 2, DEC = 128;
constexpr int MP = BATCH * SEQ;
constexpr int MROWS = MP + DEC;
constexpr int MPAD = 16640;
constexpr int NIN = 3088, NINP = 3328;
constexpr int C_GQ = 0, C_GK = 256, C_GV = 512, C_GG = 1024, C_LR = 1536, C_RQ = 1552, C_RK = 1808, C_RV = 2064, C_RG = 2576;
constexpr int NPOS = SEQ + 1;
constexpr float EPS = 1e-6f, GN_EPS = 1e-5f;

constexpr size_t O_Y = 0, O_YS = 16777216, O_GP = 16908288, O_RP = 17432576, O_GS = 17956864, O_RS = 26345472;

constexpr size_t MiB = 1u << 20;
constexpr size_t WS_CTL = 0, CTL_ZERO_BYTES = 1 * MiB;
constexpr size_t WS_WIN = 2 * MiB;
constexpr size_t WS_WOUT = 16 * MiB;
constexpr size_t WS_ROPE = 20 * MiB;
constexpr size_t WS_H = 24 * MiB;
constexpr size_t WS_MIX = 60 * MiB;
constexpr size_t WS_Z = 96 * MiB;
constexpr size_t WS_XS = 204 * MiB;
constexpr size_t WS_COMP = 208 * MiB;
constexpr size_t WS_END = 256 * MiB;
constexpr int CW_BAR = 4096;

constexpr int LDS_BYTES = 163840;
constexpr int RING_OFF = 0, RING_BYTES = 131072;
constexpr int MISC_OFF = 163840 - 256;

#define GAS __attribute__((address_space(1)))
#define LAS __attribute__((address_space(3)))
typedef unsigned short bf16;
typedef unsigned v4u __attribute__((ext_vector_type(4)));
typedef unsigned v2u __attribute__((ext_vector_type(2)));
typedef float f32x4 __attribute__((ext_vector_type(4)));
#define LDS_WAIT() asm volatile("s_waitcnt lgkmcnt(0)" ::: "memory")
#define VM_WAIT() asm volatile("s_waitcnt vmcnt(0)" ::: "memory")
__device__ __forceinline__ unsigned f2bf(float f) { unsigned u = __builtin_bit_cast(unsigned, f); return (u + 0x7fffu + ((u >> 16) & 1u)) >> 16; }
__device__ __forceinline__ unsigned pk2(float lo, float hi) { return f2bf(lo) | (f2bf(hi) << 16); }
__device__ __forceinline__ float bf2f(unsigned short b) { return __builtin_bit_cast(float, ((unsigned)b) << 16); }
__device__ __forceinline__ float bflo(unsigned w) { return __builtin_bit_cast(float, w << 16); }
__device__ __forceinline__ float bfhi(unsigned w) { return __builtin_bit_cast(float, w & 0xffff0000u); }

#define XB_TMO      128
#define XB_XCNT(j)  (256  + 64 * (j))
#define XB_XSUB(j)  (1280 + 64 * (j))
#define XB_XGEN(j)  (2304 + 64 * (j))
#define XB_TOP      3328
#define XB_TOPGEN   3392
#define XCD_BAR_WORDS 3456
#define XB_SPIN_CAP (1u << 18)
__device__ __forceinline__ unsigned xb_ld(unsigned* p)              { return __hip_atomic_load(p, __ATOMIC_RELAXED, __HIP_MEMORY_SCOPE_AGENT); }
__device__ __forceinline__ unsigned xb_add(unsigned* p, unsigned v) { return __hip_atomic_fetch_add(p, v, __ATOMIC_RELAXED, __HIP_MEMORY_SCOPE_AGENT); }
__device__ __forceinline__ unsigned xb_xcc_id() { return (unsigned)__builtin_amdgcn_s_getreg((3 << 11) | 20) & 0xFu; }
#define XB_SPIN(cond, bar) do { unsigned _sp = 0; while (cond) { __builtin_amdgcn_s_sleep(1); \
    if ((++_sp & 255u) == 0u) { if (xb_ld(&(bar)[XB_TMO])) break; if (_sp > XB_SPIN_CAP) { atomicAdd(&(bar)[XB_TMO], 1u); break; } } } } while (0)
struct XcdBarrier { unsigned* bar; unsigned x; volatile LAS unsigned* st; };
__device__ __forceinline__ XcdBarrier xcd_barrier_post(unsigned* bar, volatile LAS unsigned* st) {
    XcdBarrier b; b.bar = bar; b.x = xb_xcc_id(); b.st = st;
    if (threadIdx.x == 0) (void)xb_add(&bar[XB_XCNT(b.x)], 1u);
    return b;
}
__device__ __forceinline__ void xcd_barrier_complete(unsigned* bar, unsigned x, unsigned& nloc, unsigned& nx) {
    const unsigned G = gridDim.x * gridDim.y * gridDim.z;
    unsigned sum, cnt, mine, sp = 0u;
    for (;;) {
        sum = 0u; cnt = 0u; mine = 0u;
#pragma unroll
        for (unsigned j = 0; j < 16; ++j) { const unsigned c = xb_ld(&bar[XB_XCNT(j)]); sum += c; cnt += (c > 0u) ? 1u : 0u; mine = (j == x) ? c : mine; }
        if (sum == G) break;
        __builtin_amdgcn_s_sleep(1);
        if ((++sp & 255u) == 0u) { if (xb_ld(&bar[XB_TMO])) break; if (sp > XB_SPIN_CAP) { atomicAdd(&bar[XB_TMO], 1u); break; } }
    }
    nloc = mine > 0u ? mine : 1u; nx = cnt > 0u ? cnt : 1u;
}
__device__ __forceinline__ void xcd_barrier(const XcdBarrier& b) {
    asm volatile("s_waitcnt vmcnt(0)" ::: "memory");
    __syncthreads();
    if (threadIdx.x == 0) {
        unsigned* bar = b.bar;
        __builtin_amdgcn_s_waitcnt(0);
        unsigned nloc = b.st[0], nx = b.st[1];
        if (nloc == 0u) { xcd_barrier_complete(bar, b.x, nloc, nx); b.st[0] = nloc; b.st[1] = nx; }
        const unsigned old = xb_add(&bar[XB_XSUB(b.x)], 1u);
        const unsigned gen = old / nloc;
        if (old + 1u == (gen + 1u) * nloc) {
            __builtin_amdgcn_fence(__ATOMIC_RELEASE, "agent");
            asm volatile("s_waitcnt vmcnt(0)" ::: "memory");
            const unsigned og = xb_add(&bar[XB_TOP], 1u);
            const unsigned tg = og / nx;
            if (og + 1u == (tg + 1u) * nx) xb_add(&bar[XB_TOPGEN], 1u);
            else XB_SPIN(xb_ld(&bar[XB_TOPGEN]) == tg, bar);
            __builtin_amdgcn_fence(__ATOMIC_ACQUIRE, "agent");
            xb_add(&bar[XB_XGEN(b.x)], 1u);
            asm volatile("s_waitcnt vmcnt(0)" ::: "memory");
        } else {
            XB_SPIN(xb_ld(&bar[XB_XGEN(b.x)]) == gen, bar);
            __builtin_amdgcn_fence(__ATOMIC_ACQUIRE, "agent");
            asm volatile("s_waitcnt vmcnt(0)" ::: "memory");
        }
    }
    __syncthreads();
}

struct Args {
    const float* x_prompt; const float* x_sample; const float* state_gla; const float* state_ret; const float* norm_w; const float* w_in;
    const float* gla_w2; const float* gla_b; const float* gla_norm_w; const float* ret_norm_w; const float* ret_norm_b; const float* w_out; const float* final_norm_w;
    float* out; unsigned char* ws; int ph_lo, ph_hi;
};
struct Frame {
    LAS unsigned char* lds; int tid, lane, wave, vcu, G;
};

__device__ __forceinline__ float wave_sum(float v) {
#pragma unroll
    for (int o = 1; o < 64; o <<= 1) v += __shfl_xor(v, o);
    return v;
}

__device__ __forceinline__ void p0_transpose_item(const float* W, int K, int N, bf16* WT, LAS float* scr, int item, int nblk, int lane, int s0a, int s0b, int s1a, int s1b) {
    const int kb = item / nblk, nb = item % nblk, k0 = 64 * kb, n0 = 32 * nb;
    const int ncol = n0 + (lane & 31);
    const float sc = ((ncol >= s0a && ncol < s0b) || (ncol >= s1a && ncol < s1b)) ? 0.125f : 1.0f;
#pragma unroll 8
    for (int i = 0; i < 32; ++i) { const int kk = 2 * i + (lane >> 5); scr[kk * 33 + (lane & 31)] = (ncol < N) ? W[(size_t)(k0 + kk) * N + ncol] * sc : 0.f; }
    LDS_WAIT(); asm volatile("" ::: "memory");
    const int c = lane & 7;
#pragma unroll
    for (int j = 0; j < 4; ++j) { const int n = (lane >> 3) + 8 * j; const LAS float* s = scr + (8 * c) * 33 + n;
        v4u o; o.x = pk2(s[0 * 33], s[1 * 33]); o.y = pk2(s[2 * 33], s[3 * 33]); o.z = pk2(s[4 * 33], s[5 * 33]); o.w = pk2(s[6 * 33], s[7 * 33]);
        *(GAS v4u*)(WT + (size_t)(n0 + n) * K + k0 + 8 * c) = o; }
    LDS_WAIT(); asm volatile("" ::: "memory");
}
__device__ __forceinline__ void rms_row_to_bf16(int lane, const float* xrow, const float* w, bf16* orow) {
    const GAS f32x4* xr = (const GAS f32x4*)xrow + lane; const GAS f32x4* wr = (const GAS f32x4*)w + lane;
    f32x4 v[4]; float s2 = 0.f;
#pragma unroll
    for (int j = 0; j < 4; ++j) { v[j] = xr[64 * j]; s2 += (v[j].x * v[j].x + v[j].y * v[j].y) + (v[j].z * v[j].z + v[j].w * v[j].w); }
    const float rs = 1.f / sqrtf(wave_sum(s2) * (1.f / D) + EPS);
    GAS unsigned long long* o8 = (GAS unsigned long long*)orow + lane;
#pragma unroll
    for (int j = 0; j < 4; ++j) { const f32x4 ww = wr[64 * j]; o8[64 * j] = (unsigned long long)pk2(v[j].x * rs * ww.x, v[j].y * rs * ww.y) | ((unsigned long long)pk2(v[j].z * rs * ww.z, v[j].w * rs * ww.w) << 32); }
}
__device__ __forceinline__ void rms_row_to_f32(int lane, const float* xrow, const float* w, float* orow) {
    const GAS f32x4* xr = (const GAS f32x4*)xrow + lane; const GAS f32x4* wr = (const GAS f32x4*)w + lane;
    f32x4 v[4]; float s2 = 0.f;
#pragma unroll
    for (int j = 0; j < 4; ++j) { v[j] = xr[64 * j]; s2 += (v[j].x * v[j].x + v[j].y * v[j].y) + (v[j].z * v[j].z + v[j].w * v[j].w); }
    const float rs = 1.f / sqrtf(wave_sum(s2) * (1.f / D) + EPS);
    GAS f32x4* o = (GAS f32x4*)orow + lane;
#pragma unroll
    for (int j = 0; j < 4; ++j) { const f32x4 ww = wr[64 * j]; o[64 * j] = (f32x4){v[j].x * rs * ww.x, v[j].y * rs * ww.y, v[j].z * rs * ww.z, v[j].w * rs * ww.w}; }
}
__device__ __forceinline__ void rope_sincos(int pos, int i, float& c, float& s) {
    double inv = 1.0; const double r = 0.74989420933245582730;
    for (int k = 0; k < i; ++k) inv *= r;
    const double ang = (double)pos * inv;
    const double kq = __builtin_rint(ang * 0.63661977236758134308);
    double y = __builtin_fma(-kq, 1.57079632679489655800e+00, ang); y = __builtin_fma(-kq, 6.12323399573676603587e-17, y);
    const double y2 = y * y;
    double sp = -2.5052108385441718775e-08; sp = sp * y2 + 2.7557319223985890653e-06; sp = sp * y2 - 1.9841269841269841253e-04; sp = sp * y2 + 8.3333333333333332177e-03; sp = sp * y2 - 1.6666666666666665741e-01; sp = y + y * y2 * sp;
    double cp = 2.0876756987868098979e-09; cp = cp * y2 - 2.7557319223985888276e-07; cp = cp * y2 + 2.4801587301587301566e-05; cp = cp * y2 - 1.3888888888888889419e-03; cp = cp * y2 + 4.1666666666666664354e-02; cp = cp * y2 - 0.5; cp = 1.0 + y2 * cp;
    const int q = ((int)(long long)kq) & 3;
    const double sv = (q == 0) ? sp : (q == 1) ? cp : (q == 2) ? -sp : -cp;
    const double cv = (q == 0) ? cp : (q == 1) ? -sp : (q == 2) ? -cp : sp;
    c = (float)cv; s = (float)sv;
}
__device__ __forceinline__ void p0_prologue(const Frame& F, const Args& a) {
    LAS float* scr = (LAS float*)(F.lds + RING_OFF + F.wave * 16384);
    const int gw = F.vcu * NWAVES + F.wave, NGW = F.G * NWAVES;
    constexpr int NB_IN = NINP / 32, I_IN = (D / 64) * NB_IN, NB_O = D / 32, I_O = (D / 64) * NB_O;
    constexpr int NITEMS = 2 * I_IN + 2 * I_O;
    bf16* win = (bf16*)(a.ws + WS_WIN); bf16* wout = (bf16*)(a.ws + WS_WOUT);
    for (int it = gw; it < NITEMS; it += NGW) {
        int r = it;
        if (r < 2 * I_IN) { const int l = r / I_IN; r -= l * I_IN; p0_transpose_item(a.w_in + (size_t)l * D * NIN, D, NIN, win + (size_t)l * NINP * D, scr, r, NB_IN, F.lane, C_GQ, C_GQ + 256, C_RK, C_RK + 256); continue; }
        r -= 2 * I_IN;
        { const int l = r / I_O; r -= l * I_O; p0_transpose_item(a.w_out + (size_t)l * D * D, D, D, wout + (size_t)l * D * D, scr, r, NB_O, F.lane, 0, 0, 0, 0); }
    }
    float* rope = (float*)(a.ws + WS_ROPE);
    for (int e = (F.vcu * NWAVES * 64 + F.tid); e < NPOS * 32; e += F.G * NWAVES * 64) {
        const int p = e >> 5, i = e & 31; float c, s; rope_sincos(p == SEQ ? 16384 : p, i, c, s);
        rope[p * 64 + i] = c; rope[p * 64 + 32 + i] = s;
    }
    bf16* H = (bf16*)(a.ws + WS_H);
    for (int m = gw; m < MPAD; m += NGW) {
        if (m < MP) rms_row_to_bf16(F.lane, a.x_prompt + (size_t)m * D, a.norm_w, H + (size_t)m * D);
        else if (m < MROWS) rms_row_to_bf16(F.lane, a.x_sample + (size_t)(m - MP) * D, a.norm_w, H + (size_t)m * D);
        else { GAS unsigned long long* o8 = (GAS unsigned long long*)(H + (size_t)m * D) + F.lane;
#pragma unroll
            for (int j = 0; j < 4; ++j) o8[64 * j] = 0ull; }
    }
}

__device__ __forceinline__ void p4_norm(const Frame& F, const Args& a, int l) {
    const int gw = F.vcu * NWAVES + F.wave, NGW = F.G * NWAVES;
    bf16* H = (bf16*)(a.ws + WS_H); float* XS = (float*)(a.ws + WS_XS);
    for (int m = gw; m < MROWS; m += NGW) {
        const float* src = (m < MP) ? a.out + O_Y + (size_t)m * D : XS + (size_t)(m - MP) * D;
        if (l == 0) rms_row_to_bf16(F.lane, src, a.norm_w + D, H + (size_t)m * D);
        else rms_row_to_f32(F.lane, src, a.final_norm_w, (m < MP) ? a.out + O_Y + (size_t)m * D : a.out + O_YS + (size_t)(m - MP) * D);
    }
}

__device__ __forceinline__ float log_sigmoid(float x) { return fminf(x, 0.f) - log1pf(expf(-fabsf(x))); }
__device__ __forceinline__ float silu(float x) { return x / (1.f + expf(-x)); }
__device__ __forceinline__ void p2_item(const Frame& F, const Args& a, int l, int row0, int ntok, int pos0row, int hd, const float* s_in, float* s_out) {
    LAS float* qs = (LAS float*)(F.lds); LAS float* ks = qs + 2048; LAS float* dc = ks + 2048; LAS float* ob = dc + 2048; LAS float* st = ob + 4096;
    const bf16* Z = (const bf16*)(a.ws + WS_Z); bf16* MIX = (bf16*)(a.ws + WS_MIX); const float* rope = (const float*)(a.ws + WS_ROPE);
    const bool gla = hd < 4; const int hh = hd & 3;
    const int cq = gla ? C_GQ + 64 * hh : C_RQ + 64 * hh, ck = gla ? C_GK + 64 * hh : C_RK + 64 * hh, cv = gla ? C_GV + 128 * hh : C_RV + 128 * hh, cg = gla ? C_GG + 128 * hh : C_RG + 128 * hh;
    const float lgam = logf(1.0f - exp2f(-5.0f - (float)hh)), gam = 1.0f - exp2f(-5.0f - (float)hh);
    const int tid = F.tid;
    float S[64];
    if (tid < 128) {
#pragma unroll
        for (int f = 0; f < 64; ++f) S[f] = s_in ? s_in[f * 128 + tid] : 0.f;
    }
    (void)lgam;
    for (int t0 = 0; t0 < ntok; t0 += 32) {
        const int nb = (ntok - t0) < 32 ? (ntok - t0) : 32;
        { const int t = tid >> 4, f0 = (tid & 15) * 4;
          if (t < nb) {
            const bf16* zr = Z + (size_t)(row0 + t0 + t) * NINP;
            if (gla) {
                float pre[4];
#pragma unroll
                for (int j = 0; j < 4; ++j) pre[j] = a.gla_b[l * 256 + hh * 64 + f0 + j];
                for (int r = 0; r < 16; ++r) { const float g = bf2f(zr[C_LR + r]);
#pragma unroll
                    for (int j = 0; j < 4; ++j) pre[j] += g * a.gla_w2[(size_t)l * 16 * 256 + r * 256 + hh * 64 + f0 + j]; }
#pragma unroll
                for (int j = 0; j < 4; ++j) { dc[t * 64 + f0 + j] = expf(log_sigmoid(pre[j]) * (1.f / 16.f)); qs[t * 64 + f0 + j] = bf2f(zr[cq + f0 + j]); ks[t * 64 + f0 + j] = bf2f(zr[ck + f0 + j]); }
            } else {
                const int p = pos0row + ((pos0row == SEQ) ? 0 : (t0 + t));
#pragma unroll
                for (int j = 0; j < 4; ++j) { const int f = f0 + j, i = f & 31; const float c = rope[p * 64 + i], s = rope[p * 64 + 32 + i];
                    const float q1 = bf2f(zr[cq + i]), q2 = bf2f(zr[cq + 32 + i]), k1 = bf2f(zr[ck + i]), k2 = bf2f(zr[ck + 32 + i]);
                    qs[t * 64 + f] = (f < 32) ? q1 * c - q2 * s : q1 * s + q2 * c; ks[t * 64 + f] = (f < 32) ? k1 * c - k2 * s : k1 * s + k2 * c; dc[t * 64 + f] = gam; }
            }
          } }
        __syncthreads();
        if (tid < 128) {
            for (int t = 0; t < nb; ++t) {
                const float v = bf2f(Z[(size_t)(row0 + t0 + t) * NINP + cv + tid]);
                float o = 0.f;
#pragma unroll
                for (int f = 0; f < 64; ++f) { S[f] = dc[t * 64 + f] * S[f] + ks[t * 64 + f] * v; o += qs[t * 64 + f] * S[f]; }
                ob[t * 128 + tid] = o;
            }
        }
        __syncthreads();
        if (tid < nb) { float s = 0.f, s2 = 0.f;
            for (int d = 0; d < 128; ++d) { const float o = ob[tid * 128 + ((d + tid) & 127)]; s += o; s2 += o * o; }
            if (gla) { st[tid * 2] = 0.f; st[tid * 2 + 1] = 1.f / sqrtf(s2 * (1.f / 128.f) + EPS); }
            else { const float mu = s * (1.f / 128.f); float var = 0.f;
                for (int d = 0; d < 128; ++d) { const float o = ob[tid * 128 + ((d + tid) & 127)] - mu; var += o * o; }
                st[tid * 2] = mu; st[tid * 2 + 1] = 1.f / sqrtf(var * (1.f / 128.f) + GN_EPS); } }
        __syncthreads();
        for (int e = tid; e < nb * 128; e += 512) { const int t = e >> 7, d = e & 127;
            const float o = (ob[e] - st[t * 2]) * st[t * 2 + 1];
            const float g = bf2f(Z[(size_t)(row0 + t0 + t) * NINP + cg + d]);
            float y;
            if (gla) y = o * a.gla_norm_w[l * 128 + d] * silu(g);
            else y = (o * a.ret_norm_w[l * 512 + hh * 128 + d] + a.ret_norm_b[l * 512 + hh * 128 + d]) * silu(g);
            MIX[(size_t)(row0 + t0 + t) * D + hd * 128 + d] = (bf16)f2bf(y); }
        __syncthreads();
    }
    if (tid < 128) {
#pragma unroll
        for (int f = 0; f < 64; ++f) s_out[f * 128 + tid] = S[f];
    }
    __syncthreads();
}
__device__ __forceinline__ void p2_simple(const Frame& F, const Args& a, int l) {
    const int NIT = BATCH * 8 + DEC * 8;
    for (int it = F.vcu; it < NIT; it += F.G) {
        int row0, ntok, posrow, hd; const float* si; float* so;
        if (it < BATCH * 8) { const int b = it >> 3; hd = it & 7; const bool gla = hd < 4; const int hh = hd & 3;
            so = a.out + (gla ? O_GP : O_RP) + ((size_t)(l * BATCH + b) * 4 + hh) * 8192; si = nullptr; row0 = b * SEQ; ntok = SEQ; posrow = 0;
        } else { const int j = it - BATCH * 8, n = j >> 3; hd = j & 7; const bool gla = hd < 4; const int hh = hd & 3;
            si = (gla ? a.state_gla : a.state_ret) + ((size_t)(l * DEC + n) * 4 + hh) * 8192;
            so = a.out + (gla ? O_GS : O_RS) + ((size_t)(l * DEC + n) * 4 + hh) * 8192; row0 = MP + n; ntok = 1; posrow = SEQ;
        }
        p2_item(F, a, l, row0, ntok, posrow, hd, si, so);
    }
}


namespace p2 {
typedef short bf16x8 __attribute__((ext_vector_type(8)));
typedef float f32x16 __attribute__((ext_vector_type(16)));
typedef unsigned u32x4 __attribute__((ext_vector_type(4)));
typedef unsigned u32x2 __attribute__((ext_vector_type(2)));
typedef __bf16 bf16x2_t __attribute__((ext_vector_type(2)));
typedef float f32x2_t __attribute__((ext_vector_type(2)));
#define DI __device__ __forceinline__
#define MFMA32(a, b, c) __builtin_amdgcn_mfma_f32_32x32x16_bf16(__builtin_bit_cast(bf16x8, (a)), __builtin_bit_cast(bf16x8, (b)), (c), 0, 0, 0)
constexpr float LOG2E = 1.4426950408889634f;
constexpr int P2_SBUF = 0;
constexpr int P2_PW = 32768, P2_PWSZ = 15360;
constexpr int P2_QD = 0, P2_AT = 8192, P2_DS = 14336, P2_BL = 14592;
constexpr int P2_LBS = P2_PW + 8 * P2_PWSZ;
constexpr int P2_FLAG = P2_LBS + 256;
constexpr int P2_DEC = P2_FLAG + 256;

DI unsigned pk(float a, float b) { f32x2_t v = {a, b}; bf16x2_t r = __builtin_convertvector(v, bf16x2_t); return __builtin_bit_cast(unsigned, r); }
DI u32x4 pack8(const f32x16& x, int s) { u32x4 p; p.x = pk(x[8 * s], x[8 * s + 1]); p.y = pk(x[8 * s + 2], x[8 * s + 3]); p.z = pk(x[8 * s + 4], x[8 * s + 5]); p.w = pk(x[8 * s + 6], x[8 * s + 7]); return p; }
DI int crow(int reg, int h) { return (reg & 3) + 8 * (reg >> 2) + 4 * h; }
DI float lo16(unsigned w) { return __builtin_bit_cast(float, w << 16); }
DI float hi16(unsigned w) { return __builtin_bit_cast(float, w & 0xffff0000u); }
DI float fexp2(float x) { return __builtin_amdgcn_exp2f(x); }
DI float fast_silu(float g) { return g * __builtin_amdgcn_rcpf(1.0f + fexp2(-g * LOG2E)); }
DI float fast_logsig(float x) { const float e = fexp2(-fabsf(x) * LOG2E); return fminf(x, 0.f) - __builtin_amdgcn_logf(1.0f + e) * 0.69314718055994531f; }
DI f32x16 zero16() { f32x16 z;
#pragma unroll
    for (int i = 0; i < 16; ++i) z[i] = 0.f; return z; }
DI u32x4 frag_pred(bool p0, bool p1, bool p2_, bool p3, bool p4, bool p5, bool p6, bool p7) {
    u32x4 r; r.x = (p0 ? 0x3F80u : 0u) | (p1 ? 0x3F800000u : 0u); r.y = (p2_ ? 0x3F80u : 0u) | (p3 ? 0x3F800000u : 0u);
    r.z = (p4 ? 0x3F80u : 0u) | (p5 ? 0x3F800000u : 0u); r.w = (p6 ? 0x3F80u : 0u) | (p7 ? 0x3F800000u : 0u); return r; }
#define PERMK(s2, jj, h) (16 * (s2) + 8 * ((jj) >> 2) + 4 * (h) + ((jj) & 3))
#define NATK(s2, jj, h)  (16 * (s2) + 8 * (h) + (jj))
DI u32x4 frag_tri(int s2, int h, int fl)  { return frag_pred(PERMK(s2,0,h) <= fl, PERMK(s2,1,h) <= fl, PERMK(s2,2,h) <= fl, PERMK(s2,3,h) <= fl, PERMK(s2,4,h) <= fl, PERMK(s2,5,h) <= fl, PERMK(s2,6,h) <= fl, PERMK(s2,7,h) <= fl); }
DI u32x4 frag_iperm(int s2, int h, int fl) { return frag_pred(PERMK(s2,0,h) == fl, PERMK(s2,1,h) == fl, PERMK(s2,2,h) == fl, PERMK(s2,3,h) == fl, PERMK(s2,4,h) == fl, PERMK(s2,5,h) == fl, PERMK(s2,6,h) == fl, PERMK(s2,7,h) == fl); }
DI u32x4 frag_inat(int s2, int h, int fl)  { return frag_pred(NATK(s2,0,h) == fl, NATK(s2,1,h) == fl, NATK(s2,2,h) == fl, NATK(s2,3,h) == fl, NATK(s2,4,h) == fl, NATK(s2,5,h) == fl, NATK(s2,6,h) == fl, NATK(s2,7,h) == fl); }
DI void lds_fence() { asm volatile("s_waitcnt lgkmcnt(0)" ::: "memory"); }
DI void wait_flag(volatile LAS unsigned* p) { while (*p == 0u) __builtin_amdgcn_s_sleep(1); asm volatile("" ::: "memory"); }

DI void decode_items(const Frame& F, const Args& a, int l) {
    const int lane = F.lane, w = F.wave, pr = w >> 1, half = w & 1, hl = lane >> 5, l5 = lane & 31;
    const int item = F.vcu * 4 + pr, n = item >> 3, hd = item & 7, hh = hd & 3; const bool gla = hd < 4;
    const bf16* zr = (const bf16*)(a.ws + WS_Z) + (size_t)(MP + n) * NINP;
    const int cq = gla ? C_GQ + 64 * hh : C_RQ + 64 * hh, ck = gla ? C_GK + 64 * hh : C_RK + 64 * hh, cv = gla ? C_GV + 128 * hh : C_RV + 128 * hh, cg = gla ? C_GG + 128 * hh : C_RG + 128 * hh;
    float q, k, dec;
    if (gla) {
        float pre = a.gla_b[l * 256 + hh * 64 + lane];
#pragma unroll
        for (int r = 0; r < 16; ++r) pre += bf2f(zr[C_LR + r]) * a.gla_w2[(size_t)l * 4096 + r * 256 + hh * 64 + lane];
        dec = expf(log_sigmoid(pre) * (1.f / 16.f)); q = bf2f(zr[cq + lane]); k = bf2f(zr[ck + lane]);
    } else {
        const float* rp = (const float*)(a.ws + WS_ROPE) + (size_t)SEQ * 64; const int i = lane & 31;
        const float c = rp[i], s = rp[32 + i];
        const float q1 = bf2f(zr[cq + i]), q2 = bf2f(zr[cq + 32 + i]), k1 = bf2f(zr[ck + i]), k2 = bf2f(zr[ck + 32 + i]);
        q = (lane < 32) ? q1 * c - q2 * s : q1 * s + q2 * c; k = (lane < 32) ? k1 * c - k2 * s : k1 * s + k2 * c; dec = 1.0f - exp2f(-5.0f - (float)hh);
    }
    const u32x2 vraw = *(const u32x2*)(zr + cv + 4 * l5);
    const f32x4 v4 = {lo16(vraw.x), hi16(vraw.x), lo16(vraw.y), hi16(vraw.y)};
    const size_t sbase = ((size_t)(l * DEC + n) * 4 + hh) * 8192;
    const float* sin_ = (gla ? a.state_gla : a.state_ret) + sbase; float* sout = a.out + (gla ? O_GS : O_RS) + sbase;
    f32x4 o4 = {0.f, 0.f, 0.f, 0.f};
    f32x4 Sv[16];
#pragma unroll
    for (int r = 0; r < 16; ++r) Sv[r] = *(const GAS f32x4*)(sin_ + (size_t)(32 * half + 2 * r + hl) * 128 + 4 * l5);
#pragma unroll
    for (int r = 0; r < 16; ++r) { const int f = 32 * half + 2 * r + hl;
        const float qf = __shfl(q, f), kf = __shfl(k, f), df = __shfl(dec, f);
        const f32x4 sn = Sv[r] * df + v4 * kf; *(GAS f32x4*)(sout + (size_t)f * 128 + 4 * l5) = sn; o4 += sn * qf; }
    o4.x += __shfl_xor(o4.x, 32); o4.y += __shfl_xor(o4.y, 32); o4.z += __shfl_xor(o4.z, 32); o4.w += __shfl_xor(o4.w, 32);
    LAS f32x4* px = (LAS f32x4*)(F.lds + P2_DEC + pr * 512);
    if (half == 1 && lane < 32) px[l5] = o4;
    __syncthreads();
    if (half == 0) {
        o4 += px[l5];
        float s1 = (o4.x + o4.y) + (o4.z + o4.w), s2 = (o4.x * o4.x + o4.y * o4.y) + (o4.z * o4.z + o4.w * o4.w);
#pragma unroll
        for (int m = 1; m < 32; m <<= 1) { s1 += __shfl_xor(s1, m); s2 += __shfl_xor(s2, m); }
        const u32x2 graw = *(const u32x2*)(zr + cg + 4 * l5);
        const f32x4 g4 = {lo16(graw.x), hi16(graw.x), lo16(graw.y), hi16(graw.y)};
        f32x4 y;
        if (gla) { const float rs = 1.f / sqrtf(s2 * (1.f / 128.f) + EPS); const f32x4 wn = *(const f32x4*)(a.gla_norm_w + l * 128 + 4 * l5); y = o4 * rs * wn; }
        else { const float mu = s1 * (1.f / 128.f); const f32x4 dlt = o4 - mu; float var = (dlt.x * dlt.x + dlt.y * dlt.y) + (dlt.z * dlt.z + dlt.w * dlt.w);
#pragma unroll
            for (int m = 1; m < 32; m <<= 1) var += __shfl_xor(var, m);
            const float rs = 1.f / sqrtf(var * (1.f / 128.f) + GN_EPS);
            const f32x4 wn = *(const f32x4*)(a.ret_norm_w + l * 512 + hh * 128 + 4 * l5), bn = *(const f32x4*)(a.ret_norm_b + l * 512 + hh * 128 + 4 * l5); y = dlt * rs * wn + bn; }
        y.x *= silu(g4.x); y.y *= silu(g4.y); y.z *= silu(g4.z); y.w *= silu(g4.w);
        if (lane < 32) { u32x2 o; o.x = pk(y.x, y.y); o.y = pk(y.z, y.w); *(u32x2*)((bf16*)(a.ws + WS_MIX) + (size_t)(MP + n) * D + hd * 128 + 4 * l5) = o; }
    }
}

DI void p2_fast(const Frame& F, const Args& a, const int l, const XcdBarrier& bar) {
    const int lane = F.lane, w = F.wave, fl = lane & 31, h = lane >> 5;
    const int seq = F.vcu >> 2, jr = F.vcu & 3, b = seq >> 3, hd = seq & 7, hh = hd & 3; const bool gla = hd < 4;
    const int c = 8 * jr + w, row0 = b * SEQ + 64 * c;
    const int cq = gla ? C_GQ + 64 * hh : C_RQ + 64 * hh, ck = gla ? C_GK + 64 * hh : C_RK + 64 * hh, cv = gla ? C_GV + 128 * hh : C_RV + 128 * hh, cg = gla ? C_GG + 128 * hh : C_RG + 128 * hh;
    const bf16* Z = (const bf16*)(a.ws + WS_Z);
    LAS unsigned char* pw = F.lds + P2_PW + w * P2_PWSZ;
    LAS f32x4* sbuf = (LAS f32x4*)(F.lds + P2_SBUF);
    volatile LAS unsigned* flg = (volatile LAS unsigned*)(F.lds + P2_FLAG);
    LAS float* lbs = (LAS float*)(F.lds + P2_LBS);
    float* ucomp = (float*)(a.ws + WS_COMP) + (size_t)(seq * 4) * 8256;
    if (F.tid < 64) flg[F.tid] = 0u;
    __syncthreads();
    decode_items(F, a, l);

    f32x16 bT[2][2];
    const float lg = __builtin_amdgcn_logf(1.0f - fexp2(-5.0f - (float)hh)) * 0.69314718055994531f;
    if (gla) {
        u32x4 w2h[2], w2l[2]; float bias[2];
#pragma unroll
        for (int fb = 0; fb < 2; ++fb) { const float* wp = a.gla_w2 + (size_t)l * 4096 + (8 * h) * 256 + hh * 64 + 32 * fb + fl; float v[8];
#pragma unroll
            for (int jj = 0; jj < 8; ++jj) v[jj] = wp[jj * 256];
#pragma unroll
            for (int d = 0; d < 4; ++d) { const unsigned hi = pk(v[2 * d], v[2 * d + 1]); w2h[fb][d] = hi; w2l[fb][d] = pk(v[2 * d] - lo16(hi), v[2 * d + 1] - hi16(hi)); }
            bias[fb] = a.gla_b[l * 256 + hh * 64 + 32 * fb + fl]; }
        u32x4 ga[2];
#pragma unroll
        for (int tb = 0; tb < 2; ++tb) ga[tb] = *(const u32x4*)(Z + (size_t)(row0 + 32 * tb + fl) * NINP + C_LR + 8 * h);
        u32x4 Xh[2][2][2], Xl[2][2][2];
#pragma unroll
        for (int tb = 0; tb < 2; ++tb)
#pragma unroll
            for (int fb = 0; fb < 2; ++fb) { f32x16 acc;
#pragma unroll
                for (int i = 0; i < 16; ++i) acc[i] = bias[fb];
                acc = MFMA32(ga[tb], w2h[fb], acc); acc = MFMA32(ga[tb], w2l[fb], acc);
#pragma unroll
                for (int i = 0; i < 16; ++i) acc[i] = fast_logsig(acc[i]) * (1.f / 16.f);
#pragma unroll
                for (int s2 = 0; s2 < 2; ++s2)
#pragma unroll
                    for (int d = 0; d < 4; ++d) { const float a0 = acc[8 * s2 + 2 * d], a1 = acc[8 * s2 + 2 * d + 1]; const unsigned hi = pk(a0, a1);
                        Xh[tb][fb][s2][d] = hi; Xl[tb][fb][s2][d] = pk(a0 - lo16(hi), a1 - hi16(hi)); } }
        const u32x4 ones = {0x3F803F80u, 0x3F803F80u, 0x3F803F80u, 0x3F803F80u};
        const u32x4 tri0 = frag_tri(0, h, fl), tri1 = frag_tri(1, h, fl);
#pragma unroll
        for (int fb = 0; fb < 2; ++fb)
#pragma unroll
            for (int tb = 0; tb < 2; ++tb) { f32x16 acc = zero16();
#pragma unroll
                for (int tp = 0; tp <= tb; ++tp)
#pragma unroll
                    for (int s2 = 0; s2 < 2; ++s2) { const u32x4 uf = (tp < tb) ? ones : (s2 == 0 ? tri0 : tri1);
                        acc = MFMA32(Xh[tp][fb][s2], uf, acc); acc = MFMA32(Xl[tp][fb][s2], uf, acc); }
                bT[fb][tb] = acc; }
    } else {
#pragma unroll
        for (int fb = 0; fb < 2; ++fb)
#pragma unroll
            for (int tb = 0; tb < 2; ++tb)
#pragma unroll
                for (int i = 0; i < 16; ++i) bT[fb][tb][i] = (float)(32 * tb + fl + 1) * lg;
    }
    {
        LAS float* dsw = (LAS float*)(pw + P2_DS); LAS float* blw = (LAS float*)(pw + P2_BL);
#pragma unroll
        for (int fb = 0; fb < 2; ++fb)
#pragma unroll
            for (int i = 0; i < 16; ++i) { const float blv = __shfl(bT[fb][1][i], 31 + 32 * h);
                if (fl == 0) { blw[(fb * 2 + h) * 16 + i] = blv; dsw[(fb * 2 + h) * 16 + i] = fexp2(blv * LOG2E); } }
    }
    u32x4 qd[2][4], kd[2][4];
    const float* ropeT = (const float*)(a.ws + WS_ROPE);
#pragma unroll
    for (int tb = 0; tb < 2; ++tb) {
        const bf16* zr = Z + (size_t)(row0 + 32 * tb + fl) * NINP;
#pragma unroll
        for (int ks = 0; ks < 4; ++ks) { qd[tb][ks] = *(const u32x4*)(zr + cq + 16 * ks + 8 * h); kd[tb][ks] = *(const u32x4*)(zr + ck + 16 * ks + 8 * h); }
#pragma unroll
        for (int ks = 0; ks < 4; ++ks) {
            { auto r = __builtin_amdgcn_permlane32_swap(qd[tb][ks].x, qd[tb][ks].z, false, false); qd[tb][ks].x = r[0]; qd[tb][ks].z = r[1]; }
            { auto r = __builtin_amdgcn_permlane32_swap(qd[tb][ks].y, qd[tb][ks].w, false, false); qd[tb][ks].y = r[0]; qd[tb][ks].w = r[1]; }
            { auto r = __builtin_amdgcn_permlane32_swap(kd[tb][ks].x, kd[tb][ks].z, false, false); kd[tb][ks].x = r[0]; kd[tb][ks].z = r[1]; }
            { auto r = __builtin_amdgcn_permlane32_swap(kd[tb][ks].y, kd[tb][ks].w, false, false); kd[tb][ks].y = r[0]; kd[tb][ks].w = r[1]; }
        }
        if (!gla) {
            const float* tp = ropeT + (size_t)(64 * c + 32 * tb + fl) * 64;
#pragma unroll
            for (int k2 = 0; k2 < 2; ++k2) {
                const f32x4 ca = *(const f32x4*)(tp + 16 * k2 + 4 * h), cb = *(const f32x4*)(tp + 16 * k2 + 8 + 4 * h);
                const f32x4 sa = *(const f32x4*)(tp + 32 + 16 * k2 + 4 * h), sb_ = *(const f32x4*)(tp + 32 + 16 * k2 + 8 + 4 * h);
#pragma unroll
                for (int d = 0; d < 4; ++d) {
                    const float c0 = (d < 2) ? ca[2 * d] : cb[2 * d - 4], c1 = (d < 2) ? ca[2 * d + 1] : cb[2 * d - 3];
                    const float s0 = (d < 2) ? sa[2 * d] : sb_[2 * d - 4], s1 = (d < 2) ? sa[2 * d + 1] : sb_[2 * d - 3];
                    { const unsigned u1 = qd[tb][k2][d], u2 = qd[tb][k2 + 2][d]; const float x10 = lo16(u1), x11 = hi16(u1), x20 = lo16(u2), x21 = hi16(u2);
                      qd[tb][k2][d] = pk(x10 * c0 - x20 * s0, x11 * c1 - x21 * s1); qd[tb][k2 + 2][d] = pk(x10 * s0 + x20 * c0, x11 * s1 + x21 * c1); }
                    { const unsigned u1 = kd[tb][k2][d], u2 = kd[tb][k2 + 2][d]; const float x10 = lo16(u1), x11 = hi16(u1), x20 = lo16(u2), x21 = hi16(u2);
                      kd[tb][k2][d] = pk(x10 * c0 - x20 * s0, x11 * c1 - x21 * s1); kd[tb][k2 + 2][d] = pk(x10 * s0 + x20 * c0, x11 * s1 + x21 * c1); }
                }
            }
        }
#pragma unroll
        for (int ks = 0; ks < 4; ++ks)
#pragma unroll
            for (int d = 0; d < 4; ++d) { const int fb = ks >> 1, s2 = ks & 1;
                const float e0 = bT[fb][tb][8 * s2 + 2 * d] * LOG2E, e1 = bT[fb][tb][8 * s2 + 2 * d + 1] * LOG2E;
                const unsigned uq = qd[tb][ks][d], uk = kd[tb][ks][d];
                qd[tb][ks][d] = pk(lo16(uq) * fexp2(e0), hi16(uq) * fexp2(e1)); kd[tb][ks][d] = pk(lo16(uk) * fexp2(-e0), hi16(uk) * fexp2(-e1)); }
    }
    {
        LAS u32x4* qpark = (LAS u32x4*)(pw + P2_QD); LAS u32x4* apark = (LAS u32x4*)(pw + P2_AT);
#pragma unroll
        for (int tb = 0; tb < 2; ++tb)
#pragma unroll
            for (int ks = 0; ks < 4; ++ks) qpark[(tb * 4 + ks) * 64 + lane] = qd[tb][ks];
#pragma unroll
        for (int tb = 0; tb < 2; ++tb)
#pragma unroll
            for (int sb = 0; sb <= tb; ++sb) { f32x16 acc = zero16();
#pragma unroll
                for (int ks = 0; ks < 4; ++ks) acc = MFMA32(kd[sb][ks], qd[tb][ks], acc);
                if (sb == tb) {
#pragma unroll
                    for (int i = 0; i < 16; ++i) acc[i] = (crow(i, h) <= fl) ? acc[i] : 0.f; }
                const int idx = (tb == 0) ? 0 : (sb == 0 ? 2 : 4);
                apark[(idx + 0) * 64 + lane] = pack8(acc, 0); apark[(idx + 1) * 64 + lane] = pack8(acc, 1); }
    }
    u32x4 kdT[2][2][2];
    {
        const u32x4 ip0 = frag_iperm(0, h, fl), ip1 = frag_iperm(1, h, fl);
#pragma unroll
        for (int sb = 0; sb < 2; ++sb)
#pragma unroll
            for (int fb = 0; fb < 2; ++fb) { f32x16 zt = zero16(); zt = MFMA32(kd[sb][2 * fb], ip0, zt); zt = MFMA32(kd[sb][2 * fb + 1], ip1, zt);
                kdT[fb][sb][0] = pack8(zt, 0); kdT[fb][sb][1] = pack8(zt, 1); }
    }
    f32x16 U[2][4];
    const u32x4 in0 = frag_inat(0, h, fl), in1 = frag_inat(1, h, fl);
#pragma unroll
    for (int db = 0; db < 4; ++db) {
        U[0][db] = zero16(); U[1][db] = zero16();
#pragma unroll
        for (int sb = 0; sb < 2; ++sb) {
            const bf16* zr = Z + (size_t)(row0 + 32 * sb + fl) * NINP + cv + 32 * db + 8 * h;
            const u32x4 va0 = *(const u32x4*)(zr), va1 = *(const u32x4*)(zr + 16);
            f32x16 zt = zero16(); zt = MFMA32(va0, in0, zt); zt = MFMA32(va1, in1, zt);
            const u32x4 vt0 = pack8(zt, 0), vt1 = pack8(zt, 1);
#pragma unroll
            for (int fb = 0; fb < 2; ++fb) { U[fb][db] = MFMA32(kdT[fb][sb][0], vt0, U[fb][db]); U[fb][db] = MFMA32(kdT[fb][sb][1], vt1, U[fb][db]); }
        }
    }
    {
        lds_fence();
        if (w > 0) wait_flag(flg + w);
        const LAS f32x4* dsw = (const LAS f32x4*)(pw + P2_DS);
        float* uc = ucomp + (size_t)jr * 8256;
#pragma unroll
        for (int fb = 0; fb < 2; ++fb)
#pragma unroll
            for (int db = 0; db < 4; ++db)
#pragma unroll
                for (int q4 = 0; q4 < 4; ++q4) { const int si = ((fb * 4 + db) * 4 + q4) * 64 + lane;
                    f32x4 s4 = {0.f, 0.f, 0.f, 0.f}; if (w > 0) s4 = sbuf[si];
                    const f32x4 d4 = dsw[(fb * 2 + h) * 4 + q4];
                    const f32x4 u4 = {U[fb][db][4 * q4], U[fb][db][4 * q4 + 1], U[fb][db][4 * q4 + 2], U[fb][db][4 * q4 + 3]};
                    const f32x4 n4 = d4 * (s4 + u4);
                    if (w < 7) sbuf[si] = n4; else *(GAS f32x4*)(uc + (size_t)si * 4) = n4; }
        if (lane < 32) { const LAS float* blw = (const LAS float*)(pw + P2_BL); float v = blw[lane], v2 = blw[32 + lane];
            if (w > 0) { v += lbs[lane]; v2 += lbs[32 + lane]; }
            if (w < 7) { lbs[lane] = v; lbs[32 + lane] = v2; } else { uc[8192 + lane] = fexp2(v * LOG2E); uc[8192 + 32 + lane] = fexp2(v2 * LOG2E); } }
        lds_fence();
        if (w < 7) flg[w + 1] = 1u;
    }
    xcd_barrier(bar);
    {
        const int fb = w >> 2;
#pragma unroll
        for (int q4 = 0; q4 < 4; ++q4) { const int si = (w * 4 + q4) * 64 + lane; f32x4 s4 = {0.f, 0.f, 0.f, 0.f};
            for (int i = 0; i < jr; ++i) { const float* uc = ucomp + (size_t)i * 8256; const f32x4 d4 = *(const GAS f32x4*)(uc + 8192 + (fb * 2 + h) * 16 + 4 * q4); const f32x4 u4 = *(const GAS f32x4*)(uc + (size_t)si * 4); s4 = d4 * s4 + u4; }
            sbuf[si] = s4; }
    }
    __syncthreads();
    u32x4 Sp[2][4][2];
    {
        if (w > 0) wait_flag(flg + 16 + w);
        const LAS f32x4* dsw = (const LAS f32x4*)(pw + P2_DS);
        float* so = a.out + (gla ? O_GP : O_RP) + ((size_t)(l * BATCH + b) * 4 + hh) * 8192;
#pragma unroll
        for (int fb = 0; fb < 2; ++fb)
#pragma unroll
            for (int db = 0; db < 4; ++db) { f32x16 st;
#pragma unroll
                for (int q4 = 0; q4 < 4; ++q4) { const int si = ((fb * 4 + db) * 4 + q4) * 64 + lane;
                    const f32x4 s4 = sbuf[si]; const f32x4 d4 = dsw[(fb * 2 + h) * 4 + q4];
                    const f32x4 u4 = {U[fb][db][4 * q4], U[fb][db][4 * q4 + 1], U[fb][db][4 * q4 + 2], U[fb][db][4 * q4 + 3]};
                    const f32x4 n4 = d4 * (s4 + u4);
                    st[4 * q4] = s4.x; st[4 * q4 + 1] = s4.y; st[4 * q4 + 2] = s4.z; st[4 * q4 + 3] = s4.w;
                    if (w < 7) sbuf[si] = n4;
                    else if (jr == 3) { float* sp = so + (size_t)(32 * fb + 8 * q4 + 4 * h) * 128 + 32 * db + fl; sp[0] = n4.x; sp[128] = n4.y; sp[256] = n4.z; sp[384] = n4.w; } }
                Sp[fb][db][0] = pack8(st, 0); Sp[fb][db][1] = pack8(st, 1); }
        lds_fence();
        if (w < 7) flg[16 + w + 1] = 1u;
    }
    bf16* MIX = (bf16*)(a.ws + WS_MIX);
#pragma unroll
    for (int tb = 0; tb < 2; ++tb) {
        const LAS u32x4* qpark = (const LAS u32x4*)(pw + P2_QD); const LAS u32x4* apark = (const LAS u32x4*)(pw + P2_AT);
        u32x4 qf[4];
#pragma unroll
        for (int ks = 0; ks < 4; ++ks) qf[ks] = qpark[(tb * 4 + ks) * 64 + lane];
        u32x4 af[2][2];
#pragma unroll
        for (int sb = 0; sb <= tb; ++sb) { const int idx = (tb == 0) ? 0 : (sb == 0 ? 2 : 4); af[sb][0] = apark[idx * 64 + lane]; af[sb][1] = apark[(idx + 1) * 64 + lane]; }
        f32x16 oT[4];
#pragma unroll
        for (int db = 0; db < 4; ++db) {
            f32x16 acc = zero16();
#pragma unroll
            for (int sb = 0; sb <= tb; ++sb) {
                const bf16* zr = Z + (size_t)(row0 + 32 * sb + fl) * NINP + cv + 32 * db + 8 * h;
                const u32x4 va0 = *(const u32x4*)(zr), va1 = *(const u32x4*)(zr + 16);
                f32x16 zt = zero16(); zt = MFMA32(va0, in0, zt); zt = MFMA32(va1, in1, zt);
                acc = MFMA32(pack8(zt, 0), af[sb][0], acc); acc = MFMA32(pack8(zt, 1), af[sb][1], acc);
            }
#pragma unroll
            for (int fb = 0; fb < 2; ++fb) { acc = MFMA32(Sp[fb][db][0], qf[2 * fb], acc); acc = MFMA32(Sp[fb][db][1], qf[2 * fb + 1], acc); }
            oT[db] = acc;
        }
        float s1 = 0.f, s2 = 0.f;
#pragma unroll
        for (int db = 0; db < 4; ++db)
#pragma unroll
            for (int i = 0; i < 16; ++i) { s1 += oT[db][i]; s2 += oT[db][i] * oT[db][i]; }
        s1 += __shfl_xor(s1, 32); s2 += __shfl_xor(s2, 32);
        float mu = 0.f, rs;
        if (gla) rs = 1.f / sqrtf(s2 * (1.f / 128.f) + EPS);
        else { mu = s1 * (1.f / 128.f); float var = 0.f;
#pragma unroll
            for (int db = 0; db < 4; ++db)
#pragma unroll
                for (int i = 0; i < 16; ++i) { const float dlt = oT[db][i] - mu; var += dlt * dlt; }
            var += __shfl_xor(var, 32); rs = 1.f / sqrtf(var * (1.f / 128.f) + GN_EPS); }
        const size_t rowg = (size_t)(row0 + 32 * tb + fl);
#pragma unroll
        for (int db = 0; db < 4; ++db)
#pragma unroll
            for (int q4 = 0; q4 < 4; ++q4) { const int dv = 32 * db + 8 * q4 + 4 * h;
                const u32x2 graw = *(const u32x2*)(Z + rowg * NINP + cg + dv);
                const float g0 = lo16(graw.x), g1 = hi16(graw.x), g2 = lo16(graw.y), g3 = hi16(graw.y);
                float y0, y1, y2, y3;
                if (gla) { const f32x4 wn = *(const f32x4*)(a.gla_norm_w + l * 128 + dv);
                    y0 = oT[db][4 * q4] * rs * wn.x; y1 = oT[db][4 * q4 + 1] * rs * wn.y; y2 = oT[db][4 * q4 + 2] * rs * wn.z; y3 = oT[db][4 * q4 + 3] * rs * wn.w; }
                else { const f32x4 wn = *(const f32x4*)(a.ret_norm_w + l * 512 + hh * 128 + dv), bn = *(const f32x4*)(a.ret_norm_b + l * 512 + hh * 128 + dv);
                    y0 = (oT[db][4 * q4] - mu) * rs * wn.x + bn.x; y1 = (oT[db][4 * q4 + 1] - mu) * rs * wn.y + bn.y; y2 = (oT[db][4 * q4 + 2] - mu) * rs * wn.z + bn.z; y3 = (oT[db][4 * q4 + 3] - mu) * rs * wn.w + bn.w; }
                u32x2 o; o.x = pk(y0 * fast_silu(g0), y1 * fast_silu(g1)); o.y = pk(y2 * fast_silu(g2), y3 * fast_silu(g3));
                *(u32x2*)(MIX + rowg * D + hd * 128 + dv) = o; }
    }
}
#undef DI
}


#define IN(k) (lo <= (k) && (k) < hi)
#define SEAM(k) do { if (IN(k) && IN((k) + 1)) xcd_barrier(bar); } while (0)
template <int l>
__device__ __forceinline__ void layer_body(const Frame& F, const Args& args, const XcdBarrier& bar, const int lo, const int hi) {
        constexpr int pb = 1 + 4 * l;
        if (IN(pb)) {
            pg8::Gemm g{(const bf16*)(args.ws + WS_H), (const bf16*)(args.ws + WS_WIN) + (size_t)l * NINP * D, MPAD, NINP, D};
            pg8::StaticOrder S; S.init(MPAD, NINP, F.G, (int)blockIdx.x);
            pg8::EpiBf16 E{(bf16*)(args.ws + WS_Z), NINP};
            pg8::gemm_phase<pg8::EpiBf16, pg8::StaticOrder>(F.lds + RING_OFF, g, S, E);
            SEAM(pb);
        }
        if (IN(pb + 1)) {
#if P2_FAST
            p2::p2_fast(F, args, l, bar);
#else
            p2_simple(F, args, l);
#endif
            SEAM(pb + 1); }
        if (IN(pb + 2)) {
            pg8::Gemm g{(const bf16*)(args.ws + WS_MIX), (const bf16*)(args.ws + WS_WOUT) + (size_t)l * D * D, MPAD, D, D};
            pg8::StaticOrder S; S.init(MPAD, D, F.G, (int)blockIdx.x);
            pg8::EpiResid E{l == 0 ? args.x_prompt : args.out + O_Y, args.out + O_Y, l == 0 ? args.x_sample : (const float*)(args.ws + WS_XS), (float*)(args.ws + WS_XS), D, MP};
            pg8::gemm_phase<pg8::EpiResid, pg8::StaticOrder>(F.lds + RING_OFF, g, S, E);
            SEAM(pb + 2);
        }
        if (IN(pb + 3)) { p4_norm(F, args, l); SEAM(pb + 3); }
}
#undef IN
#undef SEAM

constexpr int N_PHASES = 9;
__global__ void __launch_bounds__(NWAVES * 64, 2) hymba_fwd(Args args) {
    extern __shared__ __attribute__((aligned(16))) unsigned char lds[];
    Frame F;
    F.lds = (LAS unsigned char*)lds;
    F.tid = threadIdx.x; F.lane = F.tid & 63; F.wave = __builtin_amdgcn_readfirstlane(F.tid >> 6);
    F.G = gridDim.x; { const int bx = blockIdx.x; F.vcu = (F.G % 8 == 0) ? (bx % 8) * (F.G / 8) + bx / 8 : bx; }
    volatile LAS unsigned* MISC = (volatile LAS unsigned*)(F.lds + MISC_OFF);
    if (F.tid < 64) MISC[F.tid] = 0u;
    __syncthreads();
    unsigned* ctl = (unsigned*)(args.ws + WS_CTL);
    XcdBarrier bar; bar.bar = ctl + CW_BAR; bar.x = 0; bar.st = nullptr;
    const int lo = args.ph_lo, hi = args.ph_hi;
    const bool multi = (hi - lo) > 1;
    if (multi) bar = xcd_barrier_post(ctl + CW_BAR, MISC + 8);
#define IN(k) (lo <= (k) && (k) < hi)
#define SEAM(k) do { if (IN(k) && IN((k) + 1)) xcd_barrier(bar); } while (0)

    if (IN(0)) { p0_prologue(F, args); SEAM(0); }
    layer_body<0>(F, args, bar, lo, hi);
    layer_body<1>(F, args, bar, lo, hi);
#undef IN
#undef SEAM
}

extern "C" void kernel_launch(void* const* d_in, const int* in_sizes, int n_in, void* d_out, int out_size, void* d_ws, size_t ws_size, hipStream_t stream) {
    static int grid = 0;
    if (grid == 0) {
        int dev = 0, cus = 0, per_cu = 0;
        if (n_in != 13 || ws_size < WS_END) { fprintf(stderr, "kernel_launch: unexpected n_in %d / ws %zu\n", n_in, ws_size); grid = -1; return; }
        if (hipGetDevice(&dev) != hipSuccess || hipDeviceGetAttribute(&cus, hipDeviceAttributeMultiprocessorCount, dev) != hipSuccess) { grid = -1; return; }
        if (hipFuncSetAttribute((const void*)hymba_fwd, hipFuncAttributeMaxDynamicSharedMemorySize, LDS_BYTES) != hipSuccess) { fprintf(stderr, "kernel_launch: hipFuncSetAttribute failed\n"); grid = -1; return; }
        if (hipOccupancyMaxActiveBlocksPerMultiprocessor(&per_cu, (const void*)hymba_fwd, NWAVES * 64, LDS_BYTES) != hipSuccess || per_cu < 1) { fprintf(stderr, "kernel_launch: occupancy query says %d\n", per_cu); per_cu = 1; }
        (void)hipGetLastError();
        grid = cus * 1;
    }
    if (grid < 0) return;
    (void)hipMemsetAsync((char*)d_ws + WS_CTL, 0, CTL_ZERO_BYTES, stream);
    Args a{};
    a.x_prompt = (const float*)d_in[0]; a.x_sample = (const float*)d_in[1]; a.state_gla = (const float*)d_in[2]; a.state_ret = (const float*)d_in[3];
    a.norm_w = (const float*)d_in[4]; a.w_in = (const float*)d_in[5]; a.gla_w2 = (const float*)d_in[6]; a.gla_b = (const float*)d_in[7];
    a.gla_norm_w = (const float*)d_in[8]; a.ret_norm_w = (const float*)d_in[9]; a.ret_norm_b = (const float*)d_in[10]; a.w_out = (const float*)d_in[11];
    a.final_norm_w = (const float*)d_in[12];
    a.out = (float*)d_out; a.ws = (unsigned char*)d_ws;
#if MK_ONE_LAUNCH
    a.ph_lo = 0; a.ph_hi = N_PHASES;
    hipLaunchKernelGGL(hymba_fwd, dim3(grid), dim3(NWAVES * 64), LDS_BYTES, stream, a);
#else
    for (int p = 0; p < N_PHASES; ++p) { a.ph_lo = p; a.ph_hi = p + 1; hipLaunchKernelGGL(hymba_fwd, dim3(grid), dim3(NWAVES * 64), LDS_BYTES, stream, a); }
#endif
}
```

```cpp
#include <hip/hip_runtime.h>
#include <cstdio>
#include <cstdint>

#ifndef DUP_PHASE
#define DUP_PHASE -1
#endif
#ifndef P2_FAST
#define P2_FAST 1
#endif
#ifndef MK_ONE_LAUNCH
#define MK_ONE_LAUNCH 1
#endif

namespace pg8 {
#define PG8_LAS __attribute__((address_space(3)))
typedef unsigned short bf16_t;
typedef short bf16x8 __attribute__((ext_vector_type(8)));
typedef float f32x4 __attribute__((ext_vector_type(4)));
typedef unsigned u32x4 __attribute__((ext_vector_type(4)));
constexpr int BM = 256, BK = 64, HALF = 128, HTB = HALF * BK * 2, STAGE_BYTES = 8 * HTB, NXCD = 8, WGM = 8;

__host__ __device__ __forceinline__ int lds_byte(int r, int c) { const int st = (r >> 4) * 2 + (c >> 5), rr = r & 15, cc = c & 31, ob = rr * 64 + cc * 2; return st * 1024 + (ob ^ (((ob >> 9) & 1) << 5)); }
__host__ __device__ __forceinline__ void stage_rc(int b, int& R, int& C) { const int st = b / 1024, sb = b % 1024, swz = sb ^ (((sb >> 9) & 1) << 5); R = (st >> 1) * 16 + swz / 64; C = (st & 1) * 32 + (swz % 64) / 2; }
__host__ __device__ __forceinline__ int perm32(int rho) { const int n = rho >> 4, i = rho & 15; return 8 * (i >> 2) + 4 * n + (i & 3); }

struct Unit { int pm, pn; };
struct Gemm { const bf16_t* A; const bf16_t* Bt; int M, N, K; };

struct StaticOrder {
    int nM, nN, nwg, G, c;
    __host__ __device__ void init(int M, int N, int G_, int c_) { nM = M / BM; nN = N / BM; nwg = nM * nN; G = G_; c = c_; }
    __host__ __device__ bool next(int i, Unit& u) const {
        const long L = (long)i * G + c; if (L >= nwg) return false;
        int wgid = (int)L; { const int q = nwg / NXCD, r = nwg % NXCD, xcd = wgid % NXCD, off = wgid / NXCD; wgid = (xcd < r ? xcd * (q + 1) : r * (q + 1) + (xcd - r) * q) + off; }
        const int nig = WGM * nN, gid = wgid / nig, fm = gid * WGM, gsz = (nM - fm) < WGM ? (nM - fm) : WGM;
        u.pm = fm + ((wgid % nig) % gsz); u.pn = (wgid % nig) / gsz; return true;
    }
    __device__ __forceinline__ void a_ready(const Unit&) const {}
    __device__ __forceinline__ void done(const Unit&) const {}
};

__device__ __forceinline__ unsigned cvt_pk_bf16(float lo, float hi) { unsigned r; asm volatile("v_cvt_pk_bf16_f32 %0, %1, %2" : "=v"(r) : "v"(lo), "v"(hi)); return r; }

struct EpiBf16 {
    static constexpr bool PERM = true, AFTER_DRAIN = false;
    bf16_t* O; int ldc;
    __device__ __forceinline__ void operator()(const f32x4 (&acc)[2][2][4][2], const Unit& u, int wr, int wc, int fr, int fq) const {
        const int row0 = u.pm * BM + wr * 64 + fr; const int col0 = u.pn * BM + wc * 32 + 8 * fq;
#pragma unroll
        for (int ai = 0; ai < 2; ++ai)
#pragma unroll
            for (int m = 0; m < 4; ++m) { bf16_t* rowp = O + (size_t)(row0 + ai * HALF + m * 16) * ldc + col0;
#pragma unroll
                for (int bj = 0; bj < 2; ++bj) { const f32x4 v0 = acc[ai][bj][m][0], v1 = acc[ai][bj][m][1];
                    u32x4 w; w.x = cvt_pk_bf16(v0[0], v0[1]); w.y = cvt_pk_bf16(v0[2], v0[3]); w.z = cvt_pk_bf16(v1[0], v1[1]); w.w = cvt_pk_bf16(v1[2], v1[3]);
                    *(u32x4*)(rowp + bj * HALF) = w; } }
    }
};
struct EpiResid {
    static constexpr bool PERM = false, AFTER_DRAIN = false;
    const float* base0; float* out0; const float* base1; float* out1; int ldc; int MP;
    __device__ __forceinline__ void operator()(const f32x4 (&acc)[2][2][4][2], const Unit& u, int wr, int wc, int fr, int fq) const {
        const int row0 = u.pm * BM + wr * 64 + fr, col0 = u.pn * BM + wc * 32 + 4 * fq;
        const bool tail = (u.pm * BM >= MP);
#pragma unroll
        for (int ai = 0; ai < 2; ++ai) {
            if (tail && ai == 1) continue;
#pragma unroll
            for (int m = 0; m < 4; ++m) {
                const int row = row0 + ai * HALF + m * 16;
                const float* bp = tail ? base1 + (size_t)(row - MP) * ldc + col0 : base0 + (size_t)row * ldc + col0;
                float* op = tail ? out1 + (size_t)(row - MP) * ldc + col0 : out0 + (size_t)row * ldc + col0;
#pragma unroll
                for (int bj = 0; bj < 2; ++bj)
#pragma unroll
                    for (int n = 0; n < 2; ++n) { const f32x4 b = *(const f32x4*)(bp + bj * HALF + n * 16); *(f32x4*)(op + bj * HALF + n * 16) = acc[ai][bj][m][n] + b; }
            }
        }
    }
};

template <class Epi, class Sched>
__device__ __forceinline__ void gemm_phase(PG8_LAS unsigned char* lds, const Gemm g, const Sched& S, const Epi& E) {
    const int tid = threadIdx.x, wid = __builtin_amdgcn_readfirstlane(tid >> 6), lane = tid & 63, wr = wid >> 2, wc = wid & 3, fr = lane & 15, fq = lane >> 4;
    const int K = g.K, nt = K / BK;
    unsigned voffA[2], voffB[2];
#pragma unroll
    for (int i = 0; i < 2; ++i) { int R, C; stage_rc(tid * 16 + i * 8192, R, C); const int Rb = Epi::PERM ? ((R & ~31) + perm32(R & 31)) : R;
        voffA[i] = (unsigned)(R * K + C) * 2u; voffB[i] = (unsigned)(Rb * K + C) * 2u; }
    const size_t kstep = (size_t)(BK * 2);
    const size_t hstep = (size_t)HALF * K * 2;
    const size_t tstep = 2 * hstep;
    const unsigned ldsw = (unsigned)wid * 1024u;
    const int aoff = lds_byte(wr * 64 + fr, fq * 8), boff = lds_byte(wc * 32 + fr, fq * 8);
#define PG8_SA(b, h) (((b) * 2 + (h)) * HTB)
#define PG8_SB(b, h) ((4 + (b) * 2 + (h)) * HTB)
#define PG8_STAGE(bufoff, gbase, voff) do { _Pragma("unroll") for (int _i = 0; _i < 2; ++_i) \
        __builtin_amdgcn_global_load_lds((const unsigned*)((const char*)(gbase) + (voff)[_i]), (PG8_LAS unsigned*)(lds + (bufoff) + ldsw + _i * 8192), 16, 0, 0); } while (0)
#define PG8_LDA(dst, b, h) do { _Pragma("unroll") for (int m = 0; m < 4; ++m) _Pragma("unroll") for (int k = 0; k < 2; ++k) dst[m][k] = *(const PG8_LAS bf16x8*)(lds + PG8_SA(b, h) + aoff + m * 2048 + k * 1024); } while (0)
#define PG8_LDB(dst, b, h) do { _Pragma("unroll") for (int n = 0; n < 2; ++n) _Pragma("unroll") for (int k = 0; k < 2; ++k) dst[n][k] = *(const PG8_LAS bf16x8*)(lds + PG8_SB(b, h) + boff + n * 2048 + k * 1024); } while (0)
#define PG8_MMA(ai, bj, At, Bt) do { __builtin_amdgcn_s_setprio(1); _Pragma("unroll") for (int m = 0; m < 4; ++m) _Pragma("unroll") for (int n = 0; n < 2; ++n) _Pragma("unroll") for (int k = 0; k < 2; ++k) \
        acc[ai][bj][m][n] = __builtin_amdgcn_mfma_f32_16x16x32_bf16(Bt[n][k], At[m][k], acc[ai][bj][m][n], 0, 0, 0); __builtin_amdgcn_s_setprio(0); } while (0)
#define PG8_WAIT_V(n) asm volatile("s_waitcnt vmcnt(" #n ")" ::: "memory")
#define PG8_WAIT_L(n) asm volatile("s_waitcnt lgkmcnt(" #n ")" ::: "memory")
#define PG8_BAR __builtin_amdgcn_s_barrier()
#define PG8_SCHED __builtin_amdgcn_sched_barrier(0)
    Unit cur, nxt; int ui = 0;
    if (!S.next(0, cur)) return;
    f32x4 acc[2][2][4][2];
#pragma unroll
    for (int a = 0; a < 2; ++a)
#pragma unroll
        for (int b = 0; b < 2; ++b)
#pragma unroll
            for (int m = 0; m < 4; ++m)
#pragma unroll
                for (int n = 0; n < 2; ++n) acc[a][b][m][n] = (f32x4){0.f, 0.f, 0.f, 0.f};
    bf16x8 At[4][2], B0[2][2], B1[2][2];
    const char* cA = (const char*)g.A + (size_t)cur.pm * tstep; const char* cB = (const char*)g.Bt + (size_t)cur.pn * tstep;
    S.a_ready(cur);
    PG8_STAGE(PG8_SB(0, 0), cB, voffB); PG8_STAGE(PG8_SB(0, 1), cB + hstep, voffB); PG8_STAGE(PG8_SA(0, 0), cA, voffA); PG8_STAGE(PG8_SA(0, 1), cA + hstep, voffA);
    if (wr == 1) PG8_BAR;
    PG8_WAIT_V(2); PG8_BAR;
    PG8_STAGE(PG8_SB(1, 0), cB + kstep, voffB); PG8_STAGE(PG8_SA(1, 0), cA + kstep, voffA); PG8_STAGE(PG8_SB(1, 1), cB + hstep + kstep, voffB);
    PG8_WAIT_V(6); PG8_BAR;
    for (;;) {
        const bool has_next = S.next(ui + 1, nxt);
        const char* nA = has_next ? (const char*)g.A + (size_t)nxt.pm * tstep : cA; const char* nB = has_next ? (const char*)g.Bt + (size_t)nxt.pn * tstep : cB;
        for (int t = 0; t < nt; t += 2) {
            const bool last = (t == nt - 2);
            const char* a1 = cA + (size_t)(t + 1) * kstep;
            const char* a2 = last ? nA : cA + (size_t)(t + 2) * kstep; const char* b2 = last ? nB : cB + (size_t)(t + 2) * kstep;
            const char* a3 = a2 + kstep; const char* b3 = b2 + kstep;
            if (last && has_next) S.a_ready(nxt);
            PG8_LDB(B0, 0, 0); PG8_LDB(B1, 0, 1); PG8_SCHED; PG8_LDA(At, 0, 0); PG8_STAGE(PG8_SA(1, 1), a1 + hstep, voffA);
            PG8_WAIT_V(8); PG8_WAIT_L(0); PG8_BAR; PG8_MMA(0, 0, At, B0); PG8_MMA(0, 1, At, B1); PG8_BAR; PG8_SCHED;
            PG8_LDA(At, 0, 1); PG8_STAGE(PG8_SB(0, 0), b2, voffB); PG8_STAGE(PG8_SB(0, 1), b2 + hstep, voffB); PG8_STAGE(PG8_SA(0, 0), a2, voffA);
            PG8_WAIT_V(8); PG8_WAIT_L(0); PG8_BAR; PG8_MMA(1, 0, At, B0); PG8_MMA(1, 1, At, B1); PG8_BAR; PG8_SCHED;
            PG8_LDB(B0, 1, 0); PG8_LDB(B1, 1, 1); PG8_SCHED; PG8_LDA(At, 1, 0); PG8_STAGE(PG8_SA(0, 1), a2 + hstep, voffA);
            PG8_WAIT_V(8); PG8_WAIT_L(0); PG8_BAR; PG8_MMA(0, 0, At, B0); PG8_MMA(0, 1, At, B1); PG8_BAR; PG8_SCHED;
            PG8_LDA(At, 1, 1); PG8_STAGE(PG8_SB(1, 0), b3, voffB); PG8_STAGE(PG8_SB(1, 1), b3 + hstep, voffB); PG8_STAGE(PG8_SA(1, 0), a3, voffA);
            PG8_WAIT_V(8); PG8_WAIT_L(0); PG8_BAR; PG8_MMA(1, 0, At, B0); PG8_MMA(1, 1, At, B1); PG8_BAR; PG8_SCHED;
        }
        if (wr == 0) PG8_BAR;
        if constexpr (!Epi::AFTER_DRAIN) { E(acc, cur, wr, wc, fr, fq); S.done(cur); }
        if (!has_next) break;
#pragma unroll
        for (int a = 0; a < 2; ++a)
#pragma unroll
            for (int b = 0; b < 2; ++b)
#pragma unroll
                for (int m = 0; m < 4; ++m)
#pragma unroll
                    for (int n = 0; n < 2; ++n) acc[a][b][m][n] = (f32x4){0.f, 0.f, 0.f, 0.f};
        cur = nxt; cA = nA; cB = nB; ++ui;
        if (wr == 1) PG8_BAR;
    }
    PG8_WAIT_V(0);
    PG8_BAR;
#undef PG8_SA
#undef PG8_SB
#undef PG8_STAGE
#undef PG8_LDA
#undef PG8_LDB
#undef PG8_MMA
#undef PG8_WAIT_V
#undef PG8_WAIT_L
#undef PG8_BAR
#undef PG8_SCHED
}
}

constexpr int NWAVES = 8;
constexpr int D = 1024, BATCH = 8, SEQ = 2048, DEPTH = 2, DEC = 128;
constexpr int MP = BATCH * SEQ;
constexpr int MROWS = MP + DEC;
constexpr int MPAD = 16640;
constexpr int NIN = 3088, NINP = 3328;
constexpr int C_GQ = 0, C_GK = 256, C_GV = 512, C_GG = 1024, C_LR = 1536, C_RQ = 1552, C_RK = 1808, C_RV = 2064, C_RG = 2576;
constexpr int NPOS = SEQ + 1;
constexpr float EPS = 1e-6f, GN_EPS = 1e-5f;

constexpr size_t O_Y = 0, O_YS = 16777216, O_GP = 16908288, O_RP = 17432576, O_GS = 17956864, O_RS = 26345472;

constexpr size_t MiB = 1u << 20;
constexpr size_t WS_CTL = 0, CTL_ZERO_BYTES = 1 * MiB;
constexpr size_t WS_WIN = 2 * MiB;
constexpr size_t WS_WOUT = 16 * MiB;
constexpr size_t WS_ROPE = 20 * MiB;
constexpr size_t WS_H = 24 * MiB;
constexpr size_t WS_MIX = 60 * MiB;
constexpr size_t WS_Z = 96 * MiB;
constexpr size_t WS_XS = 204 * MiB;
constexpr size_t WS_COMP = 208 * MiB;
constexpr size_t WS_END = 256 * MiB;
constexpr int CW_BAR = 4096;

constexpr int LDS_BYTES = 163840;
constexpr int RING_OFF = 0, RING_BYTES = 131072;
constexpr int MISC_OFF = 163840 - 256;

#define GAS __attribute__((address_space(1)))
#define LAS __attribute__((address_space(3)))
typedef unsigned short bf16;
typedef unsigned v4u __attribute__((ext_vector_type(4)));
typedef unsigned v2u __attribute__((ext_vector_type(2)));
typedef float f32x4 __attribute__((ext_vector_type(4)));
#define LDS_WAIT() asm volatile("s_waitcnt lgkmcnt(0)" ::: "memory")
#define VM_WAIT() asm volatile("s_waitcnt vmcnt(0)" ::: "memory")
__device__ __forceinline__ unsigned f2bf(float f) { unsigned u = __builtin_bit_cast(unsigned, f); return (u + 0x7fffu + ((u >> 16) & 1u)) >> 16; }
__device__ __forceinline__ unsigned pk2(float lo, float hi) { return f2bf(lo) | (f2bf(hi) << 16); }
__device__ __forceinline__ float bf2f(unsigned short b) { return __builtin_bit_cast(float, ((unsigned)b) << 16); }
__device__ __forceinline__ float bflo(unsigned w) { return __builtin_bit_cast(float, w << 16); }
__device__ __forceinline__ float bfhi(unsigned w) { return __builtin_bit_cast(float, w & 0xffff0000u); }

#define XB_TMO      128
#define XB_XCNT(j)  (256  + 64 * (j))
#define XB_XSUB(j)  (1280 + 64 * (j))
#define XB_XGEN(j)  (2304 + 64 * (j))
#define XB_TOP      3328
#define XB_TOPGEN   3392
#define XCD_BAR_WORDS 3456
#define XB_SPIN_CAP (1u << 18)
__device__ __forceinline__ unsigned xb_ld(unsigned* p)              { return __hip_atomic_load(p, __ATOMIC_RELAXED, __HIP_MEMORY_SCOPE_AGENT); }
__device__ __forceinline__ unsigned xb_add(unsigned* p, unsigned v) { return __hip_atomic_fetch_add(p, v, __ATOMIC_RELAXED, __HIP_MEMORY_SCOPE_AGENT); }
__device__ __forceinline__ unsigned xb_xcc_id() { return (unsigned)__builtin_amdgcn_s_getreg((3 << 11) | 20) & 0xFu; }
#define XB_SPIN(cond, bar) do { unsigned _sp = 0; while (cond) { __builtin_amdgcn_s_sleep(1); \
    if ((++_sp & 255u) == 0u) { if (xb_ld(&(bar)[XB_TMO])) break; if (_sp > XB_SPIN_CAP) { atomicAdd(&(bar)[XB_TMO], 1u); break; } } } } while (0)
struct XcdBarrier { unsigned* bar; unsigned x; volatile LAS unsigned* st; };
__device__ __forceinline__ XcdBarrier xcd_barrier_post(unsigned* bar, volatile LAS unsigned* st) {
    XcdBarrier b; b.bar = bar; b.x = xb_xcc_id(); b.st = st;
    if (threadIdx.x == 0) (void)xb_add(&bar[XB_XCNT(b.x)], 1u);
    return b;
}
__device__ __forceinline__ void xcd_barrier_complete(unsigned* bar, unsigned x, unsigned& nloc, unsigned& nx) {
    const unsigned G = gridDim.x * gridDim.y * gridDim.z;
    unsigned sum, cnt, mine, sp = 0u;
    for (;;) {
        sum = 0u; cnt = 0u; mine = 0u;
#pragma unroll
        for (unsigned j = 0; j < 16; ++j) { const unsigned c = xb_ld(&bar[XB_XCNT(j)]); sum += c; cnt += (c > 0u) ? 1u : 0u; mine = (j == x) ? c : mine; }
        if (sum == G) break;
        __builtin_amdgcn_s_sleep(1);
        if ((++sp & 255u) == 0u) { if (xb_ld(&bar[XB_TMO])) break; if (sp > XB_SPIN_CAP) { atomicAdd(&bar[XB_TMO], 1u); break; } }
    }
    nloc = mine > 0u ? mine : 1u; nx = cnt > 0u ? cnt : 1u;
}
__device__ __forceinline__ void xcd_barrier(const XcdBarrier& b) {
    asm volatile("s_waitcnt vmcnt(0)" ::: "memory");
    __syncthreads();
    if (threadIdx.x == 0) {
        unsigned* bar = b.bar;
        __builtin_amdgcn_s_waitcnt(0);
        unsigned nloc = b.st[0], nx = b.st[1];
        if (nloc == 0u) { xcd_barrier_complete(bar, b.x, nloc, nx); b.st[0] = nloc; b.st[1] = nx; }
        const unsigned old = xb_add(&bar[XB_XSUB(b.x)], 1u);
        const unsigned gen = old / nloc;
        if (old + 1u == (gen + 1u) * nloc) {
            __builtin_amdgcn_fence(__ATOMIC_RELEASE, "agent");
            asm volatile("s_waitcnt vmcnt(0)" ::: "memory");
            const unsigned og = xb_add(&bar[XB_TOP], 1u);
            const unsigned tg = og / nx;
            if (og + 1u == (tg + 1u) * nx) xb_add(&bar[XB_TOPGEN], 1u);
            else XB_SPIN(xb_ld(&bar[XB_TOPGEN]) == tg, bar);
            __builtin_amdgcn_fence(__ATOMIC_ACQUIRE, "agent");
            xb_add(&bar[XB_XGEN(b.x)], 1u);
            asm volatile("s_waitcnt vmcnt(0)" ::: "memory");
        } else {
            XB_SPIN(xb_ld(&bar[XB_XGEN(b.x)]) == gen, bar);
            __builtin_amdgcn_fence(__ATOMIC_ACQUIRE, "agent");
            asm volatile("s_waitcnt vmcnt(0)" ::: "memory");
        }
    }
    __syncthreads();
}

struct Args {
    const float* x_prompt; const float* x_sample; const float* state_gla; const float* state_ret; const float* norm_w; const float* w_in;
    const float* gla_w2; const float* gla_b; const float* gla_norm_w; const float* ret_norm_w; const float* ret_norm_b; const float* w_out; const float* final_norm_w;
    float* out; unsigned char* ws; int ph_lo, ph_hi;
};
struct Frame {
    LAS unsigned char* lds; int tid, lane, wave, vcu, G;
};

__device__ __forceinline__ float wave_sum(float v) {
#pragma unroll
    for (int o = 1; o < 64; o <<= 1) v += __shfl_xor(v, o);
    return v;
}

__device__ __forceinline__ void p0_transpose_item(const float* W, int K, int N, bf16* WT, LAS float* scr, int item, int nblk, int lane, int s0a, int s0b, int s1a, int s1b) {
    const int kb = item / nblk, nb = item % nblk, k0 = 64 * kb, n0 = 32 * nb;
    const int ncol = n0 + (lane & 31);
    const float sc = ((ncol >= s0a && ncol < s0b) || (ncol >= s1a && ncol < s1b)) ? 0.125f : 1.0f;
#pragma unroll 8
    for (int i = 0; i < 32; ++i) { const int kk = 2 * i + (lane >> 5); scr[kk * 33 + (lane & 31)] = (ncol < N) ? W[(size_t)(k0 + kk) * N + ncol] * sc : 0.f; }
    LDS_WAIT(); asm volatile("" ::: "memory");
    const int c = lane & 7;
#pragma unroll
    for (int j = 0; j < 4; ++j) { const int n = (lane >> 3) + 8 * j; const LAS float* s = scr + (8 * c) * 33 + n;
        v4u o; o.x = pk2(s[0 * 33], s[1 * 33]); o.y = pk2(s[2 * 33], s[3 * 33]); o.z = pk2(s[4 * 33], s[5 * 33]); o.w = pk2(s[6 * 33], s[7 * 33]);
        *(GAS v4u*)(WT + (size_t)(n0 + n) * K + k0 + 8 * c) = o; }
    LDS_WAIT(); asm volatile("" ::: "memory");
}
__device__ __forceinline__ void rms_row_to_bf16(int lane, const float* xrow, const float* w, bf16* orow) {
    const GAS f32x4* xr = (const GAS f32x4*)xrow + lane; const GAS f32x4* wr = (const GAS f32x4*)w + lane;
    f32x4 v[4]; float s2 = 0.f;
#pragma unroll
    for (int j = 0; j < 4; ++j) { v[j] = xr[64 * j]; s2 += (v[j].x * v[j].x + v[j].y * v[j].y) + (v[j].z * v[j].z + v[j].w * v[j].w); }
    const float rs = 1.f / sqrtf(wave_sum(s2) * (1.f / D) + EPS);
    GAS unsigned long long* o8 = (GAS unsigned long long*)orow + lane;
#pragma unroll
    for (int j = 0; j < 4; ++j) { const f32x4 ww = wr[64 * j]; o8[64 * j] = (unsigned long long)pk2(v[j].x * rs * ww.x, v[j].y * rs * ww.y) | ((unsigned long long)pk2(v[j].z * rs * ww.z, v[j].w * rs * ww.w) << 32); }
}
__device__ __forceinline__ void rms_row_to_f32(int lane, const float* xrow, const float* w, float* orow) {
    const GAS f32x4* xr = (const GAS f32x4*)xrow + lane; const GAS f32x4* wr = (const GAS f32x4*)w + lane;
    f32x4 v[4]; float s2 = 0.f;
#pragma unroll
    for (int j = 0; j < 4; ++j) { v[j] = xr[64 * j]; s2 += (v[j].x * v[j].x + v[j].y * v[j].y) + (v[j].z * v[j].z + v[j].w * v[j].w); }
    const float rs = 1.f / sqrtf(wave_sum(s2) * (1.f / D) + EPS);
    GAS f32x4* o = (GAS f32x4*)orow + lane;
#pragma unroll
    for (int j = 0; j < 4; ++j) { const f32x4 ww = wr[64 * j]; o[64 * j] = (f32x4){v[j].x * rs * ww.x, v[j].y * rs * ww.y, v[j].z * rs * ww.z, v[j].w * rs * ww.w}; }
}
__device__ __forceinline__ void rope_sincos(int pos, int i, float& c, float& s) {
    double inv = 1.0; const double r = 0.74989420933245582730;
    for (int k = 0; k < i; ++k) inv *= r;
    const double ang = (double)pos * inv;
    const double kq = __builtin_rint(ang * 0.63661977236758134308);
    double y = __builtin_fma(-kq, 1.57079632679489655800e+00, ang); y = __builtin_fma(-kq, 6.12323399573676603587e-17, y);
    const double y2 = y * y;
    double sp = -2.5052108385441718775e-08; sp = sp * y2 + 2.7557319223985890653e-06; sp = sp * y2 - 1.9841269841269841253e-04; sp = sp * y2 + 8.3333333333333332177e-03; sp = sp * y2 - 1.6666666666666665741e-01; sp = y + y * y2 * sp;
    double cp = 2.0876756987868098979e-09; cp = cp * y2 - 2.7557319223985888276e-07; cp = cp * y2 + 2.4801587301587301566e-05; cp = cp * y2 - 1.3888888888888889419e-03; cp = cp * y2 + 4.1666666666666664354e-02; cp = cp * y2 - 0.5; cp = 1.0 + y2 * cp;
    const int q = ((int)(long long)kq) & 3;
    const double sv = (q == 0) ? sp : (q == 1) ? cp : (q == 2) ? -sp : -cp;
    const double cv = (q == 0) ? cp : (q == 1) ? -sp : (q == 2) ? -cp : sp;
    c = (float)cv; s = (float)sv;
}
__device__ __forceinline__ void p0_prologue(const Frame& F, const Args& a) {
    LAS float* scr = (LAS float*)(F.lds + RING_OFF + F.wave * 16384);
    const int gw = F.vcu * NWAVES + F.wave, NGW = F.G * NWAVES;
    constexpr int NB_IN = NINP / 32, I_IN = (D / 64) * NB_IN, NB_O = D / 32, I_O = (D / 64) * NB_O;
    constexpr int NITEMS = 2 * I_IN + 2 * I_O;
    bf16* win = (bf16*)(a.ws + WS_WIN); bf16* wout = (bf16*)(a.ws + WS_WOUT);
    for (int it = gw; it < NITEMS; it += NGW) {
        int r = it;
        if (r < 2 * I_IN) { const int l = r / I_IN; r -= l * I_IN; p0_transpose_item(a.w_in + (size_t)l * D * NIN, D, NIN, win + (size_t)l * NINP * D, scr, r, NB_IN, F.lane, C_GQ, C_GQ + 256, C_RK, C_RK + 256); continue; }
        r -= 2 * I_IN;
        { const int l = r / I_O; r -= l * I_O; p0_transpose_item(a.w_out + (size_t)l * D * D, D, D, wout + (size_t)l * D * D, scr, r, NB_O, F.lane, 0, 0, 0, 0); }
    }
    float* rope = (float*)(a.ws + WS_ROPE);
    for (int e = (F.vcu * NWAVES * 64 + F.tid); e < NPOS * 32; e += F.G * NWAVES * 64) {
        const int p = e >> 5, i = e & 31; float c, s; rope_sincos(p == SEQ ? 16384 : p, i, c, s);
        rope[p * 64 + i] = c; rope[p * 64 + 32 + i] = s;
    }
    bf16* H = (bf16*)(a.ws + WS_H);
    for (int m = gw; m < MPAD; m += NGW) {
        if (m < MP) rms_row_to_bf16(F.lane, a.x_prompt + (size_t)m * D, a.norm_w, H + (size_t)m * D);
        else if (m < MROWS) rms_row_to_bf16(F.lane, a.x_sample + (size_t)(m - MP) * D, a.norm_w, H + (size_t)m * D);
        else { GAS unsigned long long* o8 = (GAS unsigned long long*)(H + (size_t)m * D) + F.lane;
#pragma unroll
            for (int j = 0; j < 4; ++j) o8[64 * j] = 0ull; }
    }
}

__device__ __forceinline__ void p4_norm(const Frame& F, const Args& a, int l) {
    const int gw = F.vcu * NWAVES + F.wave, NGW = F.G * NWAVES;
    bf16* H = (bf16*)(a.ws + WS_H); float* XS = (float*)(a.ws + WS_XS);
    for (int m = gw; m < MROWS; m += NGW) {
        const float* src = (m < MP) ? a.out + O_Y + (size_t)m * D : XS + (size_t)(m - MP) * D;
        if (l == 0) rms_row_to_bf16(F.lane, src, a.norm_w + D, H + (size_t)m * D);
        else rms_row_to_f32(F.lane, src, a.final_norm_w, (m < MP) ? a.out + O_Y + (size_t)m * D : a.out + O_YS + (size_t)(m - MP) * D);
    }
}

__device__ __forceinline__ float log_sigmoid(float x) { return fminf(x, 0.f) - log1pf(expf(-fabsf(x))); }
__device__ __forceinline__ float silu(float x) { return x / (1.f + expf(-x)); }
__device__ __forceinline__ void p2_item(const Frame& F, const Args& a, int l, int row0, int ntok, int pos0row, int hd, const float* s_in, float* s_out) {
    LAS float* qs = (LAS float*)(F.lds); LAS float* ks = qs + 2048; LAS float* dc = ks + 2048; LAS float* ob = dc + 2048; LAS float* st = ob + 4096;
    const bf16* Z = (const bf16*)(a.ws + WS_Z); bf16* MIX = (bf16*)(a.ws + WS_MIX); const float* rope = (const float*)(a.ws + WS_ROPE);
    const bool gla = hd < 4; const int hh = hd & 3;
    const int cq = gla ? C_GQ + 64 * hh : C_RQ + 64 * hh, ck = gla ? C_GK + 64 * hh : C_RK + 64 * hh, cv = gla ? C_GV + 128 * hh : C_RV + 128 * hh, cg = gla ? C_GG + 128 * hh : C_RG + 128 * hh;
    const float lgam = logf(1.0f - exp2f(-5.0f - (float)hh)), gam = 1.0f - exp2f(-5.0f - (float)hh);
    const int tid = F.tid;
    float S[64];
    if (tid < 128) {
#pragma unroll
        for (int f = 0; f < 64; ++f) S[f] = s_in ? s_in[f * 128 + tid] : 0.f;
    }
    (void)lgam;
    for (int t0 = 0; t0 < ntok; t0 += 32) {
        const int nb = (ntok - t0) < 32 ? (ntok - t0) : 32;
        { const int t = tid >> 4, f0 = (tid & 15) * 4;
          if (t < nb) {
            const bf16* zr = Z + (size_t)(row0 + t0 + t) * NINP;
            if (gla) {
                float pre[4];
#pragma unroll
                for (int j = 0; j < 4; ++j) pre[j] = a.gla_b[l * 256 + hh * 64 + f0 + j];
                for (int r = 0; r < 16; ++r) { const float g = bf2f(zr[C_LR + r]);
#pragma unroll
                    for (int j = 0; j < 4; ++j) pre[j] += g * a.gla_w2[(size_t)l * 16 * 256 + r * 256 + hh * 64 + f0 + j]; }
#pragma unroll
                for (int j = 0; j < 4; ++j) { dc[t * 64 + f0 + j] = expf(log_sigmoid(pre[j]) * (1.f / 16.f)); qs[t * 64 + f0 + j] = bf2f(zr[cq + f0 + j]); ks[t * 64 + f0 + j] = bf2f(zr[ck + f0 + j]); }
            } else {
                const int p = pos0row + ((pos0row == SEQ) ? 0 : (t0 + t));
#pragma unroll
                for (int j = 0; j < 4; ++j) { const int f = f0 + j, i = f & 31; const float c = rope[p * 64 + i], s = rope[p * 64 + 32 + i];
                    const float q1 = bf2f(zr[cq + i]), q2 = bf2f(zr[cq + 32 + i]), k1 = bf2f(zr[ck + i]), k2 = bf2f(zr[ck + 32 + i]);
                    qs[t * 64 + f] = (f < 32) ? q1 * c - q2 * s : q1 * s + q2 * c; ks[t * 64 + f] = (f < 32) ? k1 * c - k2 * s : k1 * s + k2 * c; dc[t * 64 + f] = gam; }
            }
          } }
        __syncthreads();
        if (tid < 128) {
            for (int t = 0; t < nb; ++t) {
                const float v = bf2f(Z[(size_t)(row0 + t0 + t) * NINP + cv + tid]);
                float o = 0.f;
#pragma unroll
                for (int f = 0; f < 64; ++f) { S[f] = dc[t * 64 + f] * S[f] + ks[t * 64 + f] * v; o += qs[t * 64 + f] * S[f]; }
                ob[t * 128 + tid] = o;
            }
        }
        __syncthreads();
        if (tid < nb) { float s = 0.f, s2 = 0.f;
            for (int d = 0; d < 128; ++d) { const float o = ob[tid * 128 + ((d + tid) & 127)]; s += o; s2 += o * o; }
            if (gla) { st[tid * 2] = 0.f; st[tid * 2 + 1] = 1.f / sqrtf(s2 * (1.f / 128.f) + EPS); }
            else { const float mu = s * (1.f / 128.f); float var = 0.f;
                for (int d = 0; d < 128; ++d) { const float o = ob[tid * 128 + ((d + tid) & 127)] - mu; var += o * o; }
                st[tid * 2] = mu; st[tid * 2 + 1] = 1.f / sqrtf(var * (1.f / 128.f) + GN_EPS); } }
        __syncthreads();
        for (int e = tid; e < nb * 128; e += 512) { const int t = e >> 7, d = e & 127;
            const float o = (ob[e] - st[t * 2]) * st[t * 2 + 1];
            const float g = bf2f(Z[(size_t)(row0 + t0 + t) * NINP + cg + d]);
            float y;
            if (gla) y = o * a.gla_norm_w[l * 128 + d] * silu(g);
            else y = (o * a.ret_norm_w[l * 512 + hh * 128 + d] + a.ret_norm_b[l * 512 + hh * 128 + d]) * silu(g);
            MIX[(size_t)(row0 + t0 + t) * D + hd * 128 + d] = (bf16)f2bf(y); }
        __syncthreads();
    }
    if (tid < 128) {
#pragma unroll
        for (int f = 0; f < 64; ++f) s_out[f * 128 + tid] = S[f];
    }
    __syncthreads();
}
__device__ __forceinline__ void p2_simple(const Frame& F, const Args& a, int l) {
    const int NIT = BATCH * 8 + DEC * 8;
    for (int it = F.vcu; it < NIT; it += F.G) {
        int row0, ntok, posrow, hd; const float* si; float* so;
        if (it < BATCH * 8) { const int b = it >> 3; hd = it & 7; const bool gla = hd < 4; const int hh = hd & 3;
            so = a.out + (gla ? O_GP : O_RP) + ((size_t)(l * BATCH + b) * 4 + hh) * 8192; si = nullptr; row0 = b * SEQ; ntok = SEQ; posrow = 0;
        } else { const int j = it - BATCH * 8, n = j >> 3; hd = j & 7; const bool gla = hd < 4; const int hh = hd & 3;
            si = (gla ? a.state_gla : a.state_ret) + ((size_t)(l * DEC + n) * 4 + hh) * 8192;
            so = a.out + (gla ? O_GS : O_RS) + ((size_t)(l * DEC + n) * 4 + hh) * 8192; row0 = MP + n; ntok = 1; posrow = SEQ;
        }
        p2_item(F, a, l, row0, ntok, posrow, hd, si, so);
    }
}


namespace p2 {
typedef short bf16x8 __attribute__((ext_vector_type(8)));
typedef float f32x16 __attribute__((ext_vector_type(16)));
typedef unsigned u32x4 __attribute__((ext_vector_type(4)));
typedef unsigned u32x2 __attribute__((ext_vector_type(2)));
typedef __bf16 bf16x2_t __attribute__((ext_vector_type(2)));
typedef float f32x2_t __attribute__((ext_vector_type(2)));
#define DI __device__ __forceinline__
#define MFMA32(a, b, c) __builtin_amdgcn_mfma_f32_32x32x16_bf16(__builtin_bit_cast(bf16x8, (a)), __builtin_bit_cast(bf16x8, (b)), (c), 0, 0, 0)
constexpr float LOG2E = 1.4426950408889634f;
constexpr int P2_SBUF = 0;
constexpr int P2_PW = 32768, P2_PWSZ = 15360;
constexpr int P2_QD = 0, P2_AT = 8192, P2_DS = 14336, P2_BL = 14592;
constexpr int P2_LBS = P2_PW + 8 * P2_PWSZ;
constexpr int P2_FLAG = P2_LBS + 256;
constexpr int P2_DEC = P2_FLAG + 512;
constexpr int P2_WT = P2_DEC + 2048;

DI unsigned pk(float a, float b) { f32x2_t v = {a, b}; bf16x2_t r = __builtin_convertvector(v, bf16x2_t); return __builtin_bit_cast(unsigned, r); }
DI u32x4 pack8(const f32x16& x, int s) { u32x4 p; p.x = pk(x[8 * s], x[8 * s + 1]); p.y = pk(x[8 * s + 2], x[8 * s + 3]); p.z = pk(x[8 * s + 4], x[8 * s + 5]); p.w = pk(x[8 * s + 6], x[8 * s + 7]); return p; }
DI int crow(int reg, int h) { return (reg & 3) + 8 * (reg >> 2) + 4 * h; }
DI float lo16(unsigned w) { return __builtin_bit_cast(float, w << 16); }
DI float hi16(unsigned w) { return __builtin_bit_cast(float, w & 0xffff0000u); }
DI float fexp2(float x) { return __builtin_amdgcn_exp2f(x); }
DI float fast_silu(float g) { return g * __builtin_amdgcn_rcpf(1.0f + fexp2(-g * LOG2E)); }
DI float fast_logsig(float x) { const float e = fexp2(-fabsf(x) * LOG2E); return fminf(x, 0.f) - __builtin_amdgcn_logf(1.0f + e) * 0.69314718055994531f; }
DI f32x16 zero16() { f32x16 z;
#pragma unroll
    for (int i = 0; i < 16; ++i) z[i] = 0.f; return z; }
DI u32x4 frag_pred(bool p0, bool p1, bool p2_, bool p3, bool p4, bool p5, bool p6, bool p7) {
    u32x4 r; r.x = (p0 ? 0x3F80u : 0u) | (p1 ? 0x3F800000u : 0u); r.y = (p2_ ? 0x3F80u : 0u) | (p3 ? 0x3F800000u : 0u);
    r.z = (p4 ? 0x3F80u : 0u) | (p5 ? 0x3F800000u : 0u); r.w = (p6 ? 0x3F80u : 0u) | (p7 ? 0x3F800000u : 0u); return r; }
#define PERMK(s2, jj, h) (16 * (s2) + 8 * ((jj) >> 2) + 4 * (h) + ((jj) & 3))
#define NATK(s2, jj, h)  (16 * (s2) + 8 * (h) + (jj))
DI u32x4 frag_tri(int s2, int h, int fl)  { return frag_pred(PERMK(s2,0,h) <= fl, PERMK(s2,1,h) <= fl, PERMK(s2,2,h) <= fl, PERMK(s2,3,h) <= fl, PERMK(s2,4,h) <= fl, PERMK(s2,5,h) <= fl, PERMK(s2,6,h) <= fl, PERMK(s2,7,h) <= fl); }
DI u32x4 frag_iperm(int s2, int h, int fl) { return frag_pred(PERMK(s2,0,h) == fl, PERMK(s2,1,h) == fl, PERMK(s2,2,h) == fl, PERMK(s2,3,h) == fl, PERMK(s2,4,h) == fl, PERMK(s2,5,h) == fl, PERMK(s2,6,h) == fl, PERMK(s2,7,h) == fl); }
DI u32x4 frag_inat(int s2, int h, int fl)  { return frag_pred(NATK(s2,0,h) == fl, NATK(s2,1,h) == fl, NATK(s2,2,h) == fl, NATK(s2,3,h) == fl, NATK(s2,4,h) == fl, NATK(s2,5,h) == fl, NATK(s2,6,h) == fl, NATK(s2,7,h) == fl); }
DI void lds_fence() { asm volatile("s_waitcnt lgkmcnt(0)" ::: "memory"); }
DI void wait_flag(volatile LAS unsigned* p) { while (*p == 0u) __builtin_amdgcn_s_sleep(1); asm volatile("" ::: "memory"); }

DI void decode_items(const Frame& F, const Args& a, int l) {
    const int lane = F.lane, w = F.wave, pr = w >> 1, half = w & 1, hl = lane >> 5, l5 = lane & 31;
    const int item = F.vcu * 4 + pr, n = item >> 3, hd = item & 7, hh = hd & 3; const bool gla = hd < 4;
    const bf16* zr = (const bf16*)(a.ws + WS_Z) + (size_t)(MP + n) * NINP;
    const int cq = gla ? C_GQ + 64 * hh : C_RQ + 64 * hh, ck = gla ? C_GK + 64 * hh : C_RK + 64 * hh, cv = gla ? C_GV + 128 * hh : C_RV + 128 * hh, cg = gla ? C_GG + 128 * hh : C_RG + 128 * hh;
    float q, k, dec;
    if (gla) {
        float pre = a.gla_b[l * 256 + hh * 64 + lane];
#pragma unroll
        for (int r = 0; r < 16; ++r) pre += bf2f(zr[C_LR + r]) * a.gla_w2[(size_t)l * 4096 + r * 256 + hh * 64 + lane];
        dec = expf(log_sigmoid(pre) * (1.f / 16.f)); q = bf2f(zr[cq + lane]); k = bf2f(zr[ck + lane]);
    } else {
        const float* rp = (const float*)(a.ws + WS_ROPE) + (size_t)SEQ * 64; const int i = lane & 31;
        const float c = rp[i], s = rp[32 + i];
        const float q1 = bf2f(zr[cq + i]), q2 = bf2f(zr[cq + 32 + i]), k1 = bf2f(zr[ck + i]), k2 = bf2f(zr[ck + 32 + i]);
        q = (lane < 32) ? q1 * c - q2 * s : q1 * s + q2 * c; k = (lane < 32) ? k1 * c - k2 * s : k1 * s + k2 * c; dec = 1.0f - exp2f(-5.0f - (float)hh);
    }
    const u32x2 vraw = *(const u32x2*)(zr + cv + 4 * l5);
    const f32x4 v4 = {lo16(vraw.x), hi16(vraw.x), lo16(vraw.y), hi16(vraw.y)};
    const size_t sbase = ((size_t)(l * DEC + n) * 4 + hh) * 8192;
    const float* sin_ = (gla ? a.state_gla : a.state_ret) + sbase; float* sout = a.out + (gla ? O_GS : O_RS) + sbase;
    f32x4 o4 = {0.f, 0.f, 0.f, 0.f};
    f32x4 Sv[16];
#pragma unroll
    for (int r = 0; r < 16; ++r) Sv[r] = *(const GAS f32x4*)(sin_ + (size_t)(32 * half + 2 * r + hl) * 128 + 4 * l5);
#pragma unroll
    for (int r = 0; r < 16; ++r) { const int f = 32 * half + 2 * r + hl;
        const float qf = __shfl(q, f), kf = __shfl(k, f), df = __shfl(dec, f);
        const f32x4 sn = Sv[r] * df + v4 * kf; *(GAS f32x4*)(sout + (size_t)f * 128 + 4 * l5) = sn; o4 += sn * qf; }
    o4.x += __shfl_xor(o4.x, 32); o4.y += __shfl_xor(o4.y, 32); o4.z += __shfl_xor(o4.z, 32); o4.w += __shfl_xor(o4.w, 32);
    LAS f32x4* px = (LAS f32x4*)(F.lds + P2_DEC + pr * 512);
    if (half == 1 && lane < 32) px[l5] = o4;
    __syncthreads();
    if (half == 0) {
        o4 += px[l5];
        float s1 = (o4.x + o4.y) + (o4.z + o4.w), s2 = (o4.x * o4.x + o4.y * o4.y) + (o4.z * o4.z + o4.w * o4.w);
#pragma unroll
        for (int m = 1; m < 32; m <<= 1) { s1 += __shfl_xor(s1, m); s2 += __shfl_xor(s2, m); }
        const u32x2 graw = *(const u32x2*)(zr + cg + 4 * l5);
        const f32x4 g4 = {lo16(graw.x), hi16(graw.x), lo16(graw.y), hi16(graw.y)};
        f32x4 y;
        if (gla) { const float rs = 1.f / sqrtf(s2 * (1.f / 128.f) + EPS); const f32x4 wn = *(const f32x4*)(a.gla_norm_w + l * 128 + 4 * l5); y = o4 * rs * wn; }
        else { const float mu = s1 * (1.f / 128.f); const f32x4 dlt = o4 - mu; float var = (dlt.x * dlt.x + dlt.y * dlt.y) + (dlt.z * dlt.z + dlt.w * dlt.w);
#pragma unroll
            for (int m = 1; m < 32; m <<= 1) var += __shfl_xor(var, m);
            const float rs = 1.f / sqrtf(var * (1.f / 128.f) + GN_EPS);
            const f32x4 wn = *(const f32x4*)(a.ret_norm_w + l * 512 + hh * 128 + 4 * l5), bn = *(const f32x4*)(a.ret_norm_b + l * 512 + hh * 128 + 4 * l5); y = dlt * rs * wn + bn; }
        y.x *= silu(g4.x); y.y *= silu(g4.y); y.z *= silu(g4.z); y.w *= silu(g4.w);
        if (lane < 32) { u32x2 o; o.x = pk(y.x, y.y); o.y = pk(y.z, y.w); *(u32x2*)((bf16*)(a.ws + WS_MIX) + (size_t)(MP + n) * D + hd * 128 + 4 * l5) = o; }
    }
}

DI void p2_fast(const Frame& F, const Args& a, const int l, const XcdBarrier& bar) {
    const int lane = F.lane, w = F.wave, fl = lane & 31, h = lane >> 5;
    const int seq = F.vcu >> 2, jr = F.vcu & 3, b = seq >> 3, hd = seq & 7, hh = hd & 3; const bool gla = hd < 4;
    const int c = 8 * jr + w, row0 = b * SEQ + 64 * c;
    const int cq = gla ? C_GQ + 64 * hh : C_RQ + 64 * hh, ck = gla ? C_GK + 64 * hh : C_RK + 64 * hh, cv = gla ? C_GV + 128 * hh : C_RV + 128 * hh, cg = gla ? C_GG + 128 * hh : C_RG + 128 * hh;
    const bf16* Z = (const bf16*)(a.ws + WS_Z);
    LAS unsigned char* pw = F.lds + P2_PW + w * P2_PWSZ;
    LAS f32x4* sbuf = (LAS f32x4*)(F.lds + P2_SBUF);
    volatile LAS unsigned* flg = (volatile LAS unsigned*)(F.lds + P2_FLAG);
    LAS float* lbs = (LAS float*)(F.lds + P2_LBS);
    float* ucomp = (float*)(a.ws + WS_COMP) + (size_t)(seq * 4) * 8256;
    if (F.tid < 128) flg[F.tid] = 0u;
#pragma unroll
    for (int i = 0; i < 4; ++i) sbuf[F.tid + 512 * i] = (f32x4){0.f, 0.f, 0.f, 0.f};
    { LAS float* wt = (LAS float*)(F.lds + P2_WT);
      if (F.tid < 128) wt[F.tid] = gla ? a.gla_norm_w[l * 128 + F.tid] : a.ret_norm_w[l * 512 + hh * 128 + F.tid];
      else if (F.tid < 256) wt[F.tid] = gla ? 0.f : a.ret_norm_b[l * 512 + hh * 128 + F.tid - 128]; }
    __syncthreads();
    decode_items(F, a, l);

    f32x16 bT[2][2];
    const float lg = __builtin_amdgcn_logf(1.0f - fexp2(-5.0f - (float)hh)) * 0.69314718055994531f;
    if (gla) {
        u32x4 w2h[2], w2l[2]; float bias[2];
#pragma unroll
        for (int fb = 0; fb < 2; ++fb) { const float* wp = a.gla_w2 + (size_t)l * 4096 + (8 * h) * 256 + hh * 64 + 32 * fb + fl; float v[8];
#pragma unroll
            for (int jj = 0; jj < 8; ++jj) v[jj] = wp[jj * 256];
#pragma unroll
            for (int d = 0; d < 4; ++d) { const unsigned hi = pk(v[2 * d], v[2 * d + 1]); w2h[fb][d] = hi; w2l[fb][d] = pk(v[2 * d] - lo16(hi), v[2 * d + 1] - hi16(hi)); }
            bias[fb] = a.gla_b[l * 256 + hh * 64 + 32 * fb + fl]; }
        u32x4 ga[2];
#pragma unroll
        for (int tb = 0; tb < 2; ++tb) ga[tb] = *(const u32x4*)(Z + (size_t)(row0 + 32 * tb + fl) * NINP + C_LR + 8 * h);
        u32x4 Xh[2][2][2], Xl[2][2][2];
#pragma unroll
        for (int tb = 0; tb < 2; ++tb)
#pragma unroll
            for (int fb = 0; fb < 2; ++fb) { f32x16 acc;
#pragma unroll
                for (int i = 0; i < 16; ++i) acc[i] = bias[fb];
                acc = MFMA32(ga[tb], w2h[fb], acc); acc = MFMA32(ga[tb], w2l[fb], acc);
#pragma unroll
                for (int i = 0; i < 16; ++i) acc[i] = fast_logsig(acc[i]) * (1.f / 16.f);
#pragma unroll
                for (int s2 = 0; s2 < 2; ++s2)
#pragma unroll
                    for (int d = 0; d < 4; ++d) { const float a0 = acc[8 * s2 + 2 * d], a1 = acc[8 * s2 + 2 * d + 1]; const unsigned hi = pk(a0, a1);
                        Xh[tb][fb][s2][d] = hi; Xl[tb][fb][s2][d] = pk(a0 - lo16(hi), a1 - hi16(hi)); } }
        const u32x4 ones = {0x3F803F80u, 0x3F803F80u, 0x3F803F80u, 0x3F803F80u};
        const u32x4 tri0 = frag_tri(0, h, fl), tri1 = frag_tri(1, h, fl);
#pragma unroll
        for (int fb = 0; fb < 2; ++fb)
#pragma unroll
            for (int tb = 0; tb < 2; ++tb) { f32x16 acc = zero16();
#pragma unroll
                for (int tp = 0; tp <= tb; ++tp)
#pragma unroll
                    for (int s2 = 0; s2 < 2; ++s2) { const u32x4 uf = (tp < tb) ? ones : (s2 == 0 ? tri0 : tri1);
                        acc = MFMA32(Xh[tp][fb][s2], uf, acc); acc = MFMA32(Xl[tp][fb][s2], uf, acc); }
                bT[fb][tb] = acc; }
    } else {
#pragma unroll
        for (int fb = 0; fb < 2; ++fb)
#pragma unroll
            for (int tb = 0; tb < 2; ++tb)
#pragma unroll
                for (int i = 0; i < 16; ++i) bT[fb][tb][i] = (float)(32 * tb + fl + 1) * lg;
    }
    {
        LAS float* dsw = (LAS float*)(pw + P2_DS); LAS float* blw = (LAS float*)(pw + P2_BL);
#pragma unroll
        for (int fb = 0; fb < 2; ++fb)
#pragma unroll
            for (int i = 0; i < 16; ++i) { const float blv = __shfl(bT[fb][1][i], 31 + 32 * h);
                if (fl == 0) { blw[(fb * 2 + h) * 16 + i] = blv; dsw[(fb * 2 + h) * 16 + i] = fexp2(blv * LOG2E); } }
    }
    u32x4 qd[2][4], kd[2][4];
    const float* ropeT = (const float*)(a.ws + WS_ROPE);
#pragma unroll
    for (int tb = 0; tb < 2; ++tb) {
        const bf16* zr = Z + (size_t)(row0 + 32 * tb + fl) * NINP;
#pragma unroll
        for (int ks = 0; ks < 4; ++ks) { qd[tb][ks] = *(const u32x4*)(zr + cq + 16 * ks + 8 * h); kd[tb][ks] = *(const u32x4*)(zr + ck + 16 * ks + 8 * h); }
#pragma unroll
        for (int ks = 0; ks < 4; ++ks) {
            { auto r = __builtin_amdgcn_permlane32_swap(qd[tb][ks].x, qd[tb][ks].z, false, false); qd[tb][ks].x = r[0]; qd[tb][ks].z = r[1]; }
            { auto r = __builtin_amdgcn_permlane32_swap(qd[tb][ks].y, qd[tb][ks].w, false, false); qd[tb][ks].y = r[0]; qd[tb][ks].w = r[1]; }
            { auto r = __builtin_amdgcn_permlane32_swap(kd[tb][ks].x, kd[tb][ks].z, false, false); kd[tb][ks].x = r[0]; kd[tb][ks].z = r[1]; }
            { auto r = __builtin_amdgcn_permlane32_swap(kd[tb][ks].y, kd[tb][ks].w, false, false); kd[tb][ks].y = r[0]; kd[tb][ks].w = r[1]; }
        }
        if (!gla) {
            const float* tp = ropeT + (size_t)(64 * c + 32 * tb + fl) * 64;
#pragma unroll
            for (int k2 = 0; k2 < 2; ++k2) {
                const f32x4 ca = *(const f32x4*)(tp + 16 * k2 + 4 * h), cb = *(const f32x4*)(tp + 16 * k2 + 8 + 4 * h);
                const f32x4 sa = *(const f32x4*)(tp + 32 + 16 * k2 + 4 * h), sb_ = *(const f32x4*)(tp + 32 + 16 * k2 + 8 + 4 * h);
#pragma unroll
                for (int d = 0; d < 4; ++d) {
                    const float c0 = (d < 2) ? ca[2 * d] : cb[2 * d - 4], c1 = (d < 2) ? ca[2 * d + 1] : cb[2 * d - 3];
                    const float s0 = (d < 2) ? sa[2 * d] : sb_[2 * d - 4], s1 = (d < 2) ? sa[2 * d + 1] : sb_[2 * d - 3];
                    { const unsigned u1 = qd[tb][k2][d], u2 = qd[tb][k2 + 2][d]; const float x10 = lo16(u1), x11 = hi16(u1), x20 = lo16(u2), x21 = hi16(u2);
                      qd[tb][k2][d] = pk(x10 * c0 - x20 * s0, x11 * c1 - x21 * s1); qd[tb][k2 + 2][d] = pk(x10 * s0 + x20 * c0, x11 * s1 + x21 * c1); }
                    { const unsigned u1 = kd[tb][k2][d], u2 = kd[tb][k2 + 2][d]; const float x10 = lo16(u1), x11 = hi16(u1), x20 = lo16(u2), x21 = hi16(u2);
                      kd[tb][k2][d] = pk(x10 * c0 - x20 * s0, x11 * c1 - x21 * s1); kd[tb][k2 + 2][d] = pk(x10 * s0 + x20 * c0, x11 * s1 + x21 * c1); }
                }
            }
        }
#pragma unroll
        for (int ks = 0; ks < 4; ++ks)
#pragma unroll
            for (int d = 0; d < 4; ++d) { const int fb = ks >> 1, s2 = ks & 1;
                const float e0 = bT[fb][tb][8 * s2 + 2 * d] * LOG2E, e1 = bT[fb][tb][8 * s2 + 2 * d + 1] * LOG2E;
                const unsigned uq = qd[tb][ks][d], uk = kd[tb][ks][d];
                qd[tb][ks][d] = pk(lo16(uq) * fexp2(e0), hi16(uq) * fexp2(e1)); kd[tb][ks][d] = pk(lo16(uk) * fexp2(-e0), hi16(uk) * fexp2(-e1)); }
    }
    {
        LAS u32x4* qpark = (LAS u32x4*)(pw + P2_QD); LAS u32x4* apark = (LAS u32x4*)(pw + P2_AT);
#pragma unroll
        for (int tb = 0; tb < 2; ++tb)
#pragma unroll
            for (int ks = 0; ks < 4; ++ks) qpark[(tb * 4 + ks) * 64 + lane] = qd[tb][ks];
#pragma unroll
        for (int tb = 0; tb < 2; ++tb)
#pragma unroll
            for (int sb = 0; sb <= tb; ++sb) { f32x16 acc = zero16();
#pragma unroll
                for (int ks = 0; ks < 4; ++ks) acc = MFMA32(kd[sb][ks], qd[tb][ks], acc);
                if (sb == tb) {
#pragma unroll
                    for (int i = 0; i < 16; ++i) acc[i] = (crow(i, h) <= fl) ? acc[i] : 0.f; }
                const int idx = (tb == 0) ? 0 : (sb == 0 ? 2 : 4);
                apark[(idx + 0) * 64 + lane] = pack8(acc, 0); apark[(idx + 1) * 64 + lane] = pack8(acc, 1); }
    }
    u32x4 kdT[2][2][2];
    {
        const u32x4 ip0 = frag_iperm(0, h, fl), ip1 = frag_iperm(1, h, fl);
#pragma unroll
        for (int sb = 0; sb < 2; ++sb)
#pragma unroll
            for (int fb = 0; fb < 2; ++fb) { f32x16 zt = zero16(); zt = MFMA32(kd[sb][2 * fb], ip0, zt); zt = MFMA32(kd[sb][2 * fb + 1], ip1, zt);
                kdT[fb][sb][0] = pack8(zt, 0); kdT[fb][sb][1] = pack8(zt, 1); }
    }
    f32x16 U[2][4];
    const u32x4 in0 = frag_inat(0, h, fl), in1 = frag_inat(1, h, fl);
#pragma unroll
    for (int db = 0; db < 4; ++db) {
        U[0][db] = zero16(); U[1][db] = zero16();
#pragma unroll
        for (int sb = 0; sb < 2; ++sb) {
            const bf16* zr = Z + (size_t)(row0 + 32 * sb + fl) * NINP + cv + 32 * db + 8 * h;
            const u32x4 va0 = *(const u32x4*)(zr), va1 = *(const u32x4*)(zr + 16);
            f32x16 zt = zero16(); zt = MFMA32(va0, in0, zt); zt = MFMA32(va1, in1, zt);
            const u32x4 vt0 = pack8(zt, 0), vt1 = pack8(zt, 1);
#pragma unroll
            for (int fb = 0; fb < 2; ++fb) { U[fb][db] = MFMA32(kdT[fb][sb][0], vt0, U[fb][db]); U[fb][db] = MFMA32(kdT[fb][sb][1], vt1, U[fb][db]); }
        }
    }
    {
        lds_fence();
        const LAS f32x4* dsw = (const LAS f32x4*)(pw + P2_DS);
        float* uc = ucomp + (size_t)jr * 8256;
#pragma unroll
        for (int fb = 0; fb < 2; ++fb)
#pragma unroll
            for (int db = 0; db < 4; ++db) { const int T = fb * 4 + db;
                if (w > 0) wait_flag(flg + w * 8 + T);
                f32x4 n4[4];
#pragma unroll
                for (int q4 = 0; q4 < 4; ++q4) { const f32x4 s4 = sbuf[(T * 4 + q4) * 64 + lane]; const f32x4 d4 = dsw[(fb * 2 + h) * 4 + q4];
                    const f32x4 u4 = {U[fb][db][4 * q4], U[fb][db][4 * q4 + 1], U[fb][db][4 * q4 + 2], U[fb][db][4 * q4 + 3]};
                    n4[q4] = d4 * (s4 + u4); }
                if (T == 0 && lane < 32) {
                    const LAS float* blw = (const LAS float*)(pw + P2_BL); float v = blw[lane], v2 = blw[32 + lane];
                    if (w > 0) { v += lbs[lane]; v2 += lbs[32 + lane]; }
                    if (w < 7) { lbs[lane] = v; lbs[32 + lane] = v2; } else { uc[8192 + lane] = fexp2(v * LOG2E); uc[8192 + 32 + lane] = fexp2(v2 * LOG2E); } }
                if (w < 7) {
#pragma unroll
                    for (int q4 = 0; q4 < 4; ++q4) sbuf[(T * 4 + q4) * 64 + lane] = n4[q4];
                    lds_fence(); flg[(w + 1) * 8 + T] = 1u;
                } else {
#pragma unroll
                    for (int q4 = 0; q4 < 4; ++q4) *(GAS f32x4*)(uc + (size_t)((T * 4 + q4) * 64 + lane) * 4) = n4[q4];
                } }
    }
    xcd_barrier(bar);
    {
        const int fb = w >> 2;
#pragma unroll
        for (int q4 = 0; q4 < 4; ++q4) { const int si = (w * 4 + q4) * 64 + lane; f32x4 s4 = {0.f, 0.f, 0.f, 0.f};
            for (int i = 0; i < jr; ++i) { const float* uc = ucomp + (size_t)i * 8256; const f32x4 d4 = *(const GAS f32x4*)(uc + 8192 + (fb * 2 + h) * 16 + 4 * q4); const f32x4 u4 = *(const GAS f32x4*)(uc + (size_t)si * 4); s4 = d4 * s4 + u4; }
            sbuf[si] = s4; }
    }
    __syncthreads();
    u32x4 Sp[2][4][2];
    {
        const LAS f32x4* dsw = (const LAS f32x4*)(pw + P2_DS);
        float* so = a.out + (gla ? O_GP : O_RP) + ((size_t)(l * BATCH + b) * 4 + hh) * 8192;
#pragma unroll
        for (int fb = 0; fb < 2; ++fb)
#pragma unroll
            for (int db = 0; db < 4; ++db) { const int T = fb * 4 + db; f32x16 st; f32x4 n4[4];
                if (w > 0) wait_flag(flg + 64 + w * 8 + T);
#pragma unroll
                for (int q4 = 0; q4 < 4; ++q4) { const f32x4 s4 = sbuf[(T * 4 + q4) * 64 + lane]; const f32x4 d4 = dsw[(fb * 2 + h) * 4 + q4];
                    const f32x4 u4 = {U[fb][db][4 * q4], U[fb][db][4 * q4 + 1], U[fb][db][4 * q4 + 2], U[fb][db][4 * q4 + 3]};
                    n4[q4] = d4 * (s4 + u4);
                    st[4 * q4] = s4.x; st[4 * q4 + 1] = s4.y; st[4 * q4 + 2] = s4.z; st[4 * q4 + 3] = s4.w; }
                if (w < 7) {
#pragma unroll
                    for (int q4 = 0; q4 < 4; ++q4) sbuf[(T * 4 + q4) * 64 + lane] = n4[q4];
                    lds_fence(); flg[64 + (w + 1) * 8 + T] = 1u;
                } else if (jr == 3) {
#pragma unroll
                    for (int q4 = 0; q4 < 4; ++q4) { float* sp = so + (size_t)(32 * fb + 8 * q4 + 4 * h) * 128 + 32 * db + fl; sp[0] = n4[q4].x; sp[128] = n4[q4].y; sp[256] = n4[q4].z; sp[384] = n4[q4].w; }
                }
                Sp[fb][db][0] = pack8(st, 0); Sp[fb][db][1] = pack8(st, 1); }
    }
    bf16* MIX = (bf16*)(a.ws + WS_MIX);
#pragma unroll
    for (int tb = 0; tb < 2; ++tb) {
        int rowb = row0 + 32 * tb + fl; asm volatile("" : "+v"(rowb));
        const LAS u32x4* qpark = (const LAS u32x4*)(pw + P2_QD); const LAS u32x4* apark = (const LAS u32x4*)(pw + P2_AT);
        u32x4 qf[4];
#pragma unroll
        for (int ks = 0; ks < 4; ++ks) qf[ks] = qpark[(tb * 4 + ks) * 64 + lane];
        u32x4 af[2][2];
#pragma unroll
        for (int sb = 0; sb <= tb; ++sb) { const int idx = (tb == 0) ? 0 : (sb == 0 ? 2 : 4); af[sb][0] = apark[idx * 64 + lane]; af[sb][1] = apark[(idx + 1) * 64 + lane]; }
        f32x16 oT[4];
#pragma unroll
        for (int db = 0; db < 4; ++db) {
            f32x16 acc = zero16();
#pragma unroll
            for (int sb = 0; sb <= tb; ++sb) {
                const bf16* zr = Z + (size_t)(rowb + 32 * (sb - tb)) * NINP + cv + 32 * db + 8 * h;
                const u32x4 va0 = *(const u32x4*)(zr), va1 = *(const u32x4*)(zr + 16);
                f32x16 zt = zero16(); zt = MFMA32(va0, in0, zt); zt = MFMA32(va1, in1, zt);
                acc = MFMA32(pack8(zt, 0), af[sb][0], acc); acc = MFMA32(pack8(zt, 1), af[sb][1], acc);
            }
#pragma unroll
            for (int fb = 0; fb < 2; ++fb) { acc = MFMA32(Sp[fb][db][0], qf[2 * fb], acc); acc = MFMA32(Sp[fb][db][1], qf[2 * fb + 1], acc); }
            oT[db] = acc;
        }
        float s1 = 0.f, s2 = 0.f;
#pragma unroll
        for (int db = 0; db < 4; ++db)
#pragma unroll
            for (int i = 0; i < 16; ++i) { s1 += oT[db][i]; s2 += oT[db][i] * oT[db][i]; }
        s1 += __shfl_xor(s1, 32); s2 += __shfl_xor(s2, 32);
        float mu = 0.f, rs;
        if (gla) rs = 1.f / sqrtf(s2 * (1.f / 128.f) + EPS);
        else { mu = s1 * (1.f / 128.f); float var = 0.f;
#pragma unroll
            for (int db = 0; db < 4; ++db)
#pragma unroll
                for (int i = 0; i < 16; ++i) { const float dlt = oT[db][i] - mu; var += dlt * dlt; }
            var += __shfl_xor(var, 32); rs = 1.f / sqrtf(var * (1.f / 128.f) + GN_EPS); }
        const size_t rowg = (size_t)rowb;
        const LAS float* wt = (const LAS float*)(F.lds + P2_WT);
#pragma unroll
        for (int db = 0; db < 4; ++db) {
            u32x4 gq[2];
#pragma unroll
            for (int p = 0; p < 2; ++p) { gq[p] = *(const u32x4*)(Z + rowg * NINP + cg + 32 * db + 16 * p + 8 * h);
                { auto r = __builtin_amdgcn_permlane32_swap(gq[p].x, gq[p].z, false, false); gq[p].x = r[0]; gq[p].z = r[1]; }
                { auto r = __builtin_amdgcn_permlane32_swap(gq[p].y, gq[p].w, false, false); gq[p].y = r[0]; gq[p].w = r[1]; } }
#pragma unroll
            for (int p = 0; p < 2; ++p) { u32x4 ow;
#pragma unroll
                for (int e = 0; e < 2; ++e) { const int q4 = 2 * p + e, dv = 32 * db + 8 * q4 + 4 * h;
                    const unsigned ga = e == 0 ? gq[p].x : gq[p].z, gb = e == 0 ? gq[p].y : gq[p].w;
                    const float g0 = lo16(ga), g1 = hi16(ga), g2 = lo16(gb), g3 = hi16(gb);
                    const f32x4 wn = *(const LAS f32x4*)(wt + dv);
                    float y0 = (oT[db][4 * q4] - mu) * rs * wn.x, y1 = (oT[db][4 * q4 + 1] - mu) * rs * wn.y, y2 = (oT[db][4 * q4 + 2] - mu) * rs * wn.z, y3 = (oT[db][4 * q4 + 3] - mu) * rs * wn.w;
                    if (!gla) { const f32x4 bn = *(const LAS f32x4*)(wt + 128 + dv); y0 += bn.x; y1 += bn.y; y2 += bn.z; y3 += bn.w; }
                    const unsigned o0 = pk(y0 * fast_silu(g0), y1 * fast_silu(g1)), o1 = pk(y2 * fast_silu(g2), y3 * fast_silu(g3));
                    if (e == 0) { ow.x = o0; ow.y = o1; } else { ow.z = o0; ow.w = o1; } }
                { auto r = __builtin_amdgcn_permlane32_swap(ow.x, ow.z, false, false); ow.x = r[0]; ow.z = r[1]; }
                { auto r = __builtin_amdgcn_permlane32_swap(ow.y, ow.w, false, false); ow.y = r[0]; ow.w = r[1]; }
                *(u32x4*)(MIX + rowg * D + hd * 128 + 32 * db + 16 * p + 8 * h) = ow; }
        }
    }
}
#undef DI
}


#define IN(k) (lo <= (k) && (k) < hi)
#define SEAM(k) do { if (IN(k) && IN((k) + 1)) xcd_barrier(bar); } while (0)
template <int l>
__device__ __forceinline__ void layer_body(const Frame& F, const Args& args, const XcdBarrier& bar, const int lo, const int hi) {
        constexpr int pb = 1 + 4 * l;
        if (IN(pb)) for (int rep = 0; rep < (DUP_PHASE == pb ? 2 : 1); ++rep) {
            pg8::Gemm g{(const bf16*)(args.ws + WS_H), (const bf16*)(args.ws + WS_WIN) + (size_t)l * NINP * D, MPAD, NINP, D};
            pg8::StaticOrder S; S.init(MPAD, NINP, F.G, (int)blockIdx.x);
            pg8::EpiBf16 E{(bf16*)(args.ws + WS_Z), NINP};
            pg8::gemm_phase<pg8::EpiBf16, pg8::StaticOrder>(F.lds + RING_OFF, g, S, E);
            if (rep == (DUP_PHASE == pb ? 1 : 0)) SEAM(pb);
        }
        if (IN(pb + 1)) {
#if P2_FAST
            { const int nrep = (DUP_PHASE == pb + 1) ? 2 + args.ph_lo : 1;
#pragma unroll 1
              for (int rep = 0; rep < nrep; ++rep) { p2::p2_fast(F, args, l, bar); __syncthreads(); } }
#else
            p2_simple(F, args, l);
#endif
            SEAM(pb + 1); }
        if (IN(pb + 2)) for (int rep = 0; rep < (DUP_PHASE == pb + 2 ? 2 : 1); ++rep) {
            pg8::Gemm g{(const bf16*)(args.ws + WS_MIX), (const bf16*)(args.ws + WS_WOUT) + (size_t)l * D * D, MPAD, D, D};
            pg8::StaticOrder S; S.init(MPAD, D, F.G, (int)blockIdx.x);
            pg8::EpiResid E{l == 0 ? args.x_prompt : args.out + O_Y, args.out + O_Y, l == 0 ? args.x_sample : (const float*)(args.ws + WS_XS), (float*)(args.ws + WS_XS), D, MP};
            pg8::gemm_phase<pg8::EpiResid, pg8::StaticOrder>(F.lds + RING_OFF, g, S, E);
            if (rep == (DUP_PHASE == pb + 2 ? 1 : 0)) SEAM(pb + 2);
        }
        if (IN(pb + 3)) { if (DUP_PHASE == pb + 3) p4_norm(F, args, l); p4_norm(F, args, l); SEAM(pb + 3); }
}
#undef IN
#undef SEAM

constexpr int N_PHASES = 9;
__global__ void __launch_bounds__(NWAVES * 64, 2) hymba_fwd(Args args) {
    extern __shared__ __attribute__((aligned(16))) unsigned char lds[];
    Frame F;
    F.lds = (LAS unsigned char*)lds;
    F.tid = threadIdx.x; F.lane = F.tid & 63; F.wave = __builtin_amdgcn_readfirstlane(F.tid >> 6);
    F.G = gridDim.x; { const int bx = blockIdx.x; F.vcu = (F.G % 8 == 0) ? (bx % 8) * (F.G / 8) + bx / 8 : bx; }
    volatile LAS unsigned* MISC = (volatile LAS unsigned*)(F.lds + MISC_OFF);
    if (F.tid < 64) MISC[F.tid] = 0u;
    __syncthreads();
    unsigned* ctl = (unsigned*)(args.ws + WS_CTL);
    XcdBarrier bar; bar.bar = ctl + CW_BAR; bar.x = 0; bar.st = nullptr;
    const int lo = args.ph_lo, hi = args.ph_hi;
    const bool multi = (hi - lo) > 1;
    if (multi) bar = xcd_barrier_post(ctl + CW_BAR, MISC + 8);
#define IN(k) (lo <= (k) && (k) < hi)
#define SEAM(k) do { if (IN(k) && IN((k) + 1)) xcd_barrier(bar); } while (0)

    if (IN(0)) { if (DUP_PHASE == 0) p0_prologue(F, args); p0_prologue(F, args); SEAM(0); }
    layer_body<0>(F, args, bar, lo, hi);
    layer_body<1>(F, args, bar, lo, hi);
#undef IN
#undef SEAM
}

extern "C" void kernel_launch(void* const* d_in, const int* in_sizes, int n_in, void* d_out, int out_size, void* d_ws, size_t ws_size, hipStream_t stream) {
    static int grid = 0;
    if (grid == 0) {
        int dev = 0, cus = 0, per_cu = 0;
        if (n_in != 13 || ws_size < WS_END) { fprintf(stderr, "kernel_launch: unexpected n_in %d / ws %zu\n", n_in, ws_size); grid = -1; return; }
        if (hipGetDevice(&dev) != hipSuccess || hipDeviceGetAttribute(&cus, hipDeviceAttributeMultiprocessorCount, dev) != hipSuccess) { grid = -1; return; }
        if (hipFuncSetAttribute((const void*)hymba_fwd, hipFuncAttributeMaxDynamicSharedMemorySize, LDS_BYTES) != hipSuccess) { fprintf(stderr, "kernel_launch: hipFuncSetAttribute failed\n"); grid = -1; return; }
        if (hipOccupancyMaxActiveBlocksPerMultiprocessor(&per_cu, (const void*)hymba_fwd, NWAVES * 64, LDS_BYTES) != hipSuccess || per_cu < 1) { fprintf(stderr, "kernel_launch: occupancy query says %d\n", per_cu); per_cu = 1; }
        (void)hipGetLastError();
        grid = cus * 1;
    }
    if (grid < 0) return;
    (void)hipMemsetAsync((char*)d_ws + WS_CTL, 0, CTL_ZERO_BYTES, stream);
    Args a{};
    a.x_prompt = (const float*)d_in[0]; a.x_sample = (const float*)d_in[1]; a.state_gla = (const float*)d_in[2]; a.state_ret = (const float*)d_in[3];
    a.norm_w = (const float*)d_in[4]; a.w_in = (const float*)d_in[5]; a.gla_w2 = (const float*)d_in[6]; a.gla_b = (const float*)d_in[7];
    a.gla_norm_w = (const float*)d_in[8]; a.ret_norm_w = (const float*)d_in[9]; a.ret_norm_b = (const float*)d_in[10]; a.w_out = (const float*)d_in[11];
    a.final_norm_w = (const float*)d_in[12];
    a.out = (float*)d_out; a.ws = (unsigned char*)d_ws;
#if MK_ONE_LAUNCH
    a.ph_lo = 0; a.ph_hi = N_PHASES;
    hipLaunchKernelGGL(hymba_fwd, dim3(grid), dim3(NWAVES * 64), LDS_BYTES, stream, a);
#else
    for (int p = 0; p < N_PHASES; ++p) { a.ph_lo = p; a.ph_hi = p + 1; hipLaunchKernelGGL(hymba_fwd, dim3(grid), dim3(NWAVES * 64), LDS_BYTES, stream, a); }
#endif
}
```
